# Optimizing an MI355X kernel written in HIP

```python
import jax, jax.numpy as jnp
from jax import lax
import numpy as np

D_MODEL = 4096
BATCH = 2
SEQ = 8192
DEPTH = 1

HEAD_DIM = 128
HGRN_EXPAND = 128
HGRN_WIDTH = D_MODEL // 2
HGRN_HEADS = HGRN_WIDTH // HGRN_EXPAND
HGRN_VDIM = HGRN_WIDTH // HGRN_HEADS
ATTN_WIDTH = D_MODEL // 2
ATTN_HEADS = ATTN_WIDTH // HEAD_DIM
KV_HEADS = ATTN_HEADS // 4
GQA_GROUP = ATTN_HEADS // KV_HEADS
WINDOW = 128
BLOCK = 128
CHUNK = 64
D_FF = 4 * D_MODEL
PLE_DIM = 256
ROPE_THETA = 10000.0
EPS = 1e-6

kernel_name = "hybrid_hgrn2_swa_sink_encoder_layer"


def in_proj_sizes():
    return [HGRN_HEADS * HGRN_EXPAND, HGRN_HEADS * HGRN_EXPAND, HGRN_HEADS * HGRN_EXPAND,
            HGRN_WIDTH, HGRN_WIDTH,
            ATTN_HEADS * HEAD_DIM, KV_HEADS * HEAD_DIM, KV_HEADS * HEAD_DIM,
            D_MODEL, D_MODEL]


def rms_norm(x, w):
    xf = x.astype(jnp.float32)
    y = xf * lax.rsqrt(jnp.mean(xf * xf, axis=-1, keepdims=True) + EPS)
    return (y * w.astype(jnp.float32)).astype(x.dtype)


def layer_lower_bound(lb_param, layer):
    lb = jnp.cumsum(jax.nn.softmax(lb_param.astype(jnp.float32), axis=0), axis=0)
    return lb[layer]


def gla_chunkwise(q, k, v, g):
    B, S, H, K = q.shape
    V = v.shape[-1]
    N = S // CHUNK

    def to_chunks(t):
        return t.reshape(B, N, CHUNK, H, t.shape[-1]).transpose(1, 0, 3, 2, 4)

    q, k, v, g = map(to_chunks, (q, k, v, g))
    b = jnp.cumsum(g, axis=3)
    b_last = b[:, :, :, -1:, :]
    q_hat = q * jnp.exp(b)
    k_hat = k * jnp.exp(-b)
    k_tail = k * jnp.exp(b_last - b)
    causal_in_chunk = jnp.tril(jnp.ones((CHUNK, CHUNK), dtype=bool))
    a = jnp.einsum('nbhck,nbhsk->nbhcs', q_hat, k_hat)
    a = jnp.where(causal_in_chunk, a, 0.0)
    o_intra = jnp.einsum('nbhcs,nbhsv->nbhcv', a, v)
    decay = jnp.exp(b_last[:, :, :, 0, :])

    def step(state, xs):
        q_n, kt_n, v_n, d_n = xs
        o_n = jnp.einsum('bhck,bhkv->bhcv', q_n, state)
        state = d_n[..., None] * state + jnp.einsum('bhck,bhcv->bhkv', kt_n, v_n)
        return state, o_n

    s0 = jnp.zeros((B, H, K, V), jnp.float32)
    _, o_inter = lax.scan(step, s0, (q_hat, k_tail, v, decay))
    o = o_intra + o_inter
    return o.transpose(1, 0, 3, 2, 4).reshape(B, S, H, V)


def hgrn2_direction(q, f_logit, v, lb):
    B, S, H, K = q.shape
    f = lb + (1.0 - lb) * jax.nn.sigmoid(f_logit.astype(jnp.float32))
    k = (1.0 - f).reshape(B, S, H, K)
    g = jnp.log(f).reshape(B, S, H, K)
    return gla_chunkwise(q.astype(jnp.float32), k, v.astype(jnp.float32), g)


def rotary(x, positions):
    d = x.shape[-1]
    inv_freq = ROPE_THETA ** (-jnp.arange(0, d, 2, dtype=jnp.float32) / d)
    ang = positions[:, None] * inv_freq[None, :]
    cos = jnp.cos(ang)[None, :, None, :].astype(x.dtype)
    sin = jnp.sin(ang)[None, :, None, :].astype(x.dtype)
    x1, x2 = jnp.split(x, 2, axis=-1)
    return jnp.concatenate([x1 * cos - x2 * sin, x2 * cos + x1 * sin], axis=-1)


def windowed_gqa_sink(q, k, v, sink):
    B, S, H, D = q.shape
    nb = S // BLOCK
    qb = q.reshape(B, nb, BLOCK, KV_HEADS, GQA_GROUP, D)

    def band(t):
        tp = jnp.pad(t, ((0, 0), (BLOCK, BLOCK), (0, 0), (0, 0)))
        tb = tp.reshape(B, nb + 2, BLOCK, KV_HEADS, D)
        return jnp.concatenate([tb[:, :-2], tb[:, 1:-1], tb[:, 2:]], axis=2)

    kw, vw = band(k), band(v)
    s = jnp.einsum('bnqhgd,bnkhd->bnhgqk', qb, kw,
                   preferred_element_type=jnp.float32) * (D ** -0.5)
    r = jnp.arange(BLOCK)[:, None]
    c = jnp.arange(3 * BLOCK)[None, :]
    kpos = jnp.arange(nb)[:, None, None] * BLOCK - BLOCK + c[None]
    mask = (jnp.abs(c - BLOCK - r)[None] <= WINDOW) & (kpos >= 0) & (kpos < S)
    mask = mask[None, :, None, None]
    s = jnp.where(mask, s, -jnp.inf)
    sk = sink.astype(jnp.float32).reshape(KV_HEADS, GQA_GROUP)[None, None, :, :, None, None]
    m = jnp.maximum(jnp.max(s, axis=-1, keepdims=True), sk)
    pr = jnp.exp(s - m)
    denom = jnp.sum(pr, axis=-1, keepdims=True) + jnp.exp(sk - m)
    pr = (pr / denom).astype(v.dtype)
    o = jnp.einsum('bnhgqk,bnkhd->bnqhgd', pr, vw)
    return o.reshape(B, S, H * D)


def setup_inputs(seed: int = 0) -> dict:
    key = jax.random.key(seed)
    ks = jax.random.split(key, 20)
    f32 = jnp.float32
    in_width = sum(in_proj_sizes())

    def nrm(k, shape, scale):
        return jax.random.normal(k, shape, f32) * scale

    def gain(k, shape):
        return 1.0 + 0.05 * jax.random.normal(k, shape, f32)

    return {
        "x": nrm(ks[0], (BATCH, SEQ, D_MODEL), 1.0),
        "p": nrm(ks[1], (DEPTH, BATCH, SEQ, PLE_DIM), 1.0),
        "norm_mix_pre": gain(ks[2], (DEPTH, D_MODEL)),
        "norm_mix_post": gain(ks[3], (DEPTH, D_MODEL)),
        "w_in": nrm(ks[4], (DEPTH, D_MODEL, in_width), D_MODEL ** -0.5),
        "lb_fwd": nrm(ks[5], (DEPTH + 1, HGRN_HEADS * HGRN_EXPAND), 0.1),
        "lb_bwd": nrm(ks[6], (DEPTH + 1, HGRN_HEADS * HGRN_EXPAND), 0.1),
        "hgrn_norm": gain(ks[7], (DEPTH, HGRN_VDIM)),
        "attn_sink": nrm(ks[8], (DEPTH, ATTN_HEADS), 0.5),
        "w_hgrn_proj": nrm(ks[9], (DEPTH, HGRN_WIDTH, D_MODEL), HGRN_WIDTH ** -0.5),
        "w_attn_proj": nrm(ks[10], (DEPTH, ATTN_WIDTH, D_MODEL), ATTN_WIDTH ** -0.5),
        "w_out": nrm(ks[11], (DEPTH, D_MODEL, D_MODEL), D_MODEL ** -0.5),
        "norm_mlp_pre": gain(ks[12], (DEPTH, D_MODEL)),
        "norm_mlp_post": gain(ks[13], (DEPTH, D_MODEL)),
        "w_mlp_up": nrm(ks[14], (DEPTH, D_MODEL, D_FF), D_MODEL ** -0.5),
        "w_mlp_down": nrm(ks[15], (DEPTH, D_FF, D_MODEL), D_FF ** -0.5),
        "w_ple": nrm(ks[16], (DEPTH, PLE_DIM, D_MODEL), PLE_DIM ** -0.5),
        "w_ple_gate": nrm(ks[17], (DEPTH, D_MODEL, D_MODEL), D_MODEL ** -0.5),
        "norm_ple": gain(ks[18], (DEPTH, D_MODEL)),
    }


def reference(x, p, norm_mix_pre, norm_mix_post, w_in, lb_fwd, lb_bwd, hgrn_norm, attn_sink,
              w_hgrn_proj, w_attn_proj, w_out, norm_mlp_pre, norm_mlp_post, w_mlp_up,
              w_mlp_down, w_ple, w_ple_gate, norm_ple):
    B, S, _ = x.shape
    positions = jnp.arange(S, dtype=jnp.float32)
    split_at = np.cumsum(in_proj_sizes())[:-1].tolist()
    for i in range(DEPTH):
        h = rms_norm(x, norm_mix_pre[i])
        proj = jnp.einsum('bsd,de->bse', h, w_in[i])
        hq, hf_f, hf_b, hi, hg, aq, ak, av, ga, gb = jnp.split(proj, split_at, axis=-1)

        q_h = jax.nn.silu(hq).reshape(B, S, HGRN_HEADS, HGRN_EXPAND) * (HGRN_EXPAND ** -0.5)
        v_h = hi.reshape(B, S, HGRN_HEADS, HGRN_VDIM)
        o_f = hgrn2_direction(q_h, hf_f, v_h, layer_lower_bound(lb_fwd, i))
        o_b = jnp.flip(hgrn2_direction(jnp.flip(q_h, 1), jnp.flip(hf_b, 1), jnp.flip(v_h, 1),
                                       layer_lower_bound(lb_bwd, i)), 1)
        o_h = (o_f + o_b).astype(x.dtype)
        o_h = rms_norm(o_h, hgrn_norm[i]) * jax.nn.silu(hg).reshape(B, S, HGRN_HEADS, HGRN_VDIM)
        y_a = jnp.einsum('bse,ed->bsd', o_h.reshape(B, S, HGRN_WIDTH), w_hgrn_proj[i])

        qa = rotary(aq.reshape(B, S, ATTN_HEADS, HEAD_DIM), positions)
        ka = rotary(ak.reshape(B, S, KV_HEADS, HEAD_DIM), positions)
        va = av.reshape(B, S, KV_HEADS, HEAD_DIM)
        o_a = windowed_gqa_sink(qa, ka, va, attn_sink[i])
        y_b = jnp.einsum('bse,ed->bsd', o_a, w_attn_proj[i])

        y = jax.nn.sigmoid(ga) * y_a + jax.nn.sigmoid(gb) * y_b
        mix = jnp.einsum('bsd,de->bse', y, w_out[i])
        x = x + rms_norm(mix, norm_mix_post[i])

        h2 = rms_norm(x, norm_mlp_pre[i])
        u = jnp.square(jax.nn.relu(jnp.einsum('bsd,df->bsf', h2, w_mlp_up[i])))
        d = jnp.einsum('bsf,fd->bsd', u, w_mlp_down[i])
        x = x + rms_norm(d, norm_mlp_post[i])

        e = jnp.einsum('bsp,pd->bsd', p[i].astype(x.dtype), w_ple[i])
        gate = jax.nn.sigmoid(jnp.einsum('bsd,de->bse', x, w_ple_gate[i]))
        x = x + rms_norm(e * gate, norm_ple[i])
    return x
```

```cpp
#include <hip/hip_runtime.h>
#include <cstdio>
#include <cstdint>

namespace pg8 {
#define PG8_LAS __attribute__((address_space(3)))
typedef unsigned short bf16_t;
typedef short bf16x8 __attribute__((ext_vector_type(8)));
typedef float f32x4 __attribute__((ext_vector_type(4)));
typedef unsigned u32x4 __attribute__((ext_vector_type(4)));
constexpr int BM = 256, BK = 64, HALF = 128, HTB = HALF * BK * 2, STAGE_BYTES = 8 * HTB, NXCD = 8, WGM = 8;

__host__ __device__ __forceinline__ int lds_byte(int r, int c) { const int st = (r >> 4) * 2 + (c >> 5), rr = r & 15, cc = c & 31, ob = rr * 64 + cc * 2; return st * 1024 + (ob ^ (((ob >> 9) & 1) << 5)); }
__host__ __device__ __forceinline__ void stage_rc(int b, int& R, int& C) { const int st = b / 1024, sb = b % 1024, swz = sb ^ (((sb >> 9) & 1) << 5); R = (st >> 1) * 16 + swz / 64; C = (st & 1) * 32 + (swz % 64) / 2; }
__host__ __device__ __forceinline__ int perm32(int rho) { const int n = rho >> 4, i = rho & 15; return 8 * (i >> 2) + 4 * n + (i & 3); }

struct Unit { int pm, pn; };
struct Gemm { const bf16_t* A; const bf16_t* Bt; int M, N, K, lda, ldb; };

struct StaticOrder {
    int nM, nN, nwg, G, c;
    __host__ __device__ void init(int M, int N, int G_, int c_) { nM = M / BM; nN = N / BM; nwg = nM * nN; G = G_; c = c_; }
    __host__ __device__ bool next(int i, Unit& u) const {
        const long L = (long)i * G + c; if (L >= nwg) return false;
        int wgid = (int)L; { const int q = nwg / NXCD, r = nwg % NXCD, xcd = wgid % NXCD, off = wgid / NXCD; wgid = (xcd < r ? xcd * (q + 1) : r * (q + 1) + (xcd - r) * q) + off; }
        const int nig = WGM * nN, gid = wgid / nig, fm = gid * WGM, gsz = (nM - fm) < WGM ? (nM - fm) : WGM;
        u.pm = fm + ((wgid % nig) % gsz); u.pn = (wgid % nig) / gsz; return true;
    }
    __device__ __forceinline__ void a_ready(const Unit&) const {}
    __device__ __forceinline__ void done(const Unit&) const {}
};

typedef float f32x2_t __attribute__((ext_vector_type(2)));
typedef __bf16 bf16x2_t __attribute__((ext_vector_type(2)));
__device__ __forceinline__ unsigned cvt_pk_bf16(float lo, float hi) { const f32x2_t v = {lo, hi}; return __builtin_bit_cast(unsigned, __builtin_convertvector(v, bf16x2_t)); }
__device__ __forceinline__ float sigm(float x) { return __builtin_amdgcn_rcpf(1.0f + __expf(-x)); }
__device__ __forceinline__ float bflo(unsigned w) { return __uint_as_float(w << 16); }
__device__ __forceinline__ float bfhi(unsigned w) { return __uint_as_float(w & 0xffff0000u); }

template <int MODE> struct Epi {
    static constexpr bool PERM = true, AFTER_DRAIN = false;
    bf16_t* O; int ldc; const bf16_t* G1; int ldg1; const bf16_t* G2; int ldg2; float* SS;
    bf16_t* CB;
    int tkt;
    __device__ __forceinline__ void operator()(const f32x4 (&acc)[2][2][4][2], const Unit& u, int wr, int wc, int fr, int fq) const {
        if constexpr (MODE == 6) {
            const int pn = u.pn;
            const int am = (pn < 8) ? 1 : (pn < 24) ? 2 : (pn >= 32 && pn < 40) ? 3 : 0;
            bf16_t* ob; size_t rs, bs; int rsub;
            const int bb = (u.pm * BM) / 8192;
            if (pn < 32 || (pn >= 40 && pn < 52)) {
                size_t toff; int h0, nh;
                if (pn < 32) { toff = (size_t)(pn >> 3) << 25; h0 = (pn & 7) * 2; nh = 16; }
                else if (pn < 48) { toff = (size_t)128 << 20; h0 = (pn - 40) * 2; nh = 16; }
                else if (pn < 50) { toff = (size_t)160 << 20; h0 = (pn - 48) * 2; nh = 4; }
                else { toff = (size_t)168 << 20; h0 = (pn - 50) * 2; nh = 4; }
                ob = CB + toff + (size_t)(bb * nh + h0) * 8192 * 128 + wc * 32 + 8 * fq; rs = 128; bs = (size_t)8192 * 128; rsub = bb * 8192;
            } else {
                const int c2 = (pn < 40) ? (pn - 32) * 256 : (pn - 52) * 256 + 2048;
                ob = O + c2 + wc * 32 + 8 * fq; rs = (size_t)ldc; bs = HALF; rsub = 0;
            }
            if (am == 0) run<0>(acc, u, wr, wc, fr, fq, 0, ob, rs, bs, rsub); else if (am == 1) run<7>(acc, u, wr, wc, fr, fq, 1, ob, rs, bs, rsub); else if (am == 2) run<8>(acc, u, wr, wc, fr, fq, 2, ob, rs, bs, rsub); else run<9>(acc, u, wr, wc, fr, fq, 3, ob, rs, bs, rsub);
        } else if (tkt > 0) run<MODE>(acc, u, wr, wc, fr, fq, 0, O + (size_t)(u.pm * tkt + u.pn * 4 + (wc >> 1)) * (BM * BK) + 32 * (wc & 1) + 8 * fq, (size_t)BK, (size_t)2 * BM * BK, u.pm * BM);
        else run<MODE>(acc, u, wr, wc, fr, fq, 0, O + u.pn * BM + wc * 32 + 8 * fq, (size_t)ldc, (size_t)HALF, 0);
    }
    template <int MD> __device__ __forceinline__ void run(const f32x4 (&acc)[2][2][4][2], const Unit& u, int wr, int wc, int fr, int fq, int am, bf16_t* ob, size_t rs, size_t bs, int rsub) const {
        const int row0 = u.pm * BM + wr * 64 + fr, col0 = u.pn * BM + wc * 32 + 8 * fq;
#pragma unroll
        for (int ai = 0; ai < 2; ++ai) {
            u32x4 g1v[4][2], g2v[4][2];
            if (MD == 1 || MD == 5) {
#pragma unroll
                for (int m = 0; m < 4; ++m)
#pragma unroll
                    for (int bj = 0; bj < 2; ++bj) g1v[m][bj] = *(const u32x4*)(G1 + (size_t)(row0 + ai * HALF + m * 16) * ldg1 + col0 + bj * HALF);
                asm volatile("" ::: "memory");
            }
#pragma unroll
            for (int m = 0; m < 4; ++m) {
                const int row = row0 + ai * HALF + m * 16; float ssq = 0.f;
                if (MD == 2) {
#pragma unroll
                    for (int bj = 0; bj < 2; ++bj) { g1v[m][bj] = *(const u32x4*)(G1 + (size_t)row * ldg1 + col0 + bj * HALF); g2v[m][bj] = *(const u32x4*)(G2 + (size_t)row * ldg2 + col0 + bj * HALF); }
                }
#pragma unroll
                for (int bj = 0; bj < 2; ++bj) {
                    float v[8];
#pragma unroll
                    for (int j = 0; j < 4; ++j) { v[j] = acc[ai][bj][m][0][j]; v[4 + j] = acc[ai][bj][m][1][j]; }
                    if (MD == 1 || MD == 2 || MD == 5) {
                        const u32x4 a = g1v[m][bj];
                        float g[8] = {bflo(a.x), bfhi(a.x), bflo(a.y), bfhi(a.y), bflo(a.z), bfhi(a.z), bflo(a.w), bfhi(a.w)};
                        if (MD == 1) {
#pragma unroll
                            for (int j = 0; j < 8; ++j) v[j] = sigm(g[j]) * v[j];
                        } else if (MD == 5) {
#pragma unroll
                            for (int j = 0; j < 8; ++j) v[j] = g[j] * sigm(v[j]);
                        } else {
                            const u32x4 b = g2v[m][bj];
                            float h[8] = {bflo(b.x), bfhi(b.x), bflo(b.y), bfhi(b.y), bflo(b.z), bfhi(b.z), bflo(b.w), bfhi(b.w)};
#pragma unroll
                            for (int j = 0; j < 8; ++j) v[j] = g[j] + sigm(h[j]) * v[j];
                        }
                    }
                    if (MD == 7) {
#pragma unroll
                        for (int j = 0; j < 8; ++j) v[j] = v[j] * sigm(v[j]) * 0.08838834764831845f;
                    }
                    if (MD == 8) {
#pragma unroll
                        for (int j = 0; j < 8; ++j) v[j] = sigm(-v[j]);
                    }
                    if (MD == 9) {
#pragma unroll
                        for (int j = 0; j < 8; ++j) v[j] = v[j] * sigm(v[j]);
                    }
                    if (MD == 4) {
#pragma unroll
                        for (int j = 0; j < 8; ++j) { const float r = fmaxf(v[j], 0.f); v[j] = r * r; }
                    }
                    if (MD == 3 || MD == 5) {
#pragma unroll
                        for (int j = 0; j < 8; ++j) ssq += v[j] * v[j];
                    }
                    u32x4 w; w.x = cvt_pk_bf16(v[0], v[1]); w.y = cvt_pk_bf16(v[2], v[3]); w.z = cvt_pk_bf16(v[4], v[5]); w.w = cvt_pk_bf16(v[6], v[7]);
                    *(u32x4*)(ob + (size_t)(row - rsub) * rs + bj * bs) = w;
                }
                if (MD == 3 || MD == 5) {
                    ssq += __shfl_xor(ssq, 16); ssq += __shfl_xor(ssq, 32);
                    if (fq == 0) SS[(size_t)row * 64 + u.pn * 4 + wc] = ssq;
                }
            }
        }
    }
};

template <class Epi, class Sched, bool ALIGN_EPI = false, bool SP2 = false>
__device__ __forceinline__ void gemm_phase(PG8_LAS unsigned char* lds, const Gemm g, const Sched& S, const Epi& E) {
    const int tid = threadIdx.x, wid = __builtin_amdgcn_readfirstlane(tid >> 6), lane = tid & 63, wr = wid >> 2, wc = wid & 3, fr = lane & 15, fq = lane >> 4;
    const int K = g.K, nt = K / BK;
    unsigned voffA[2], voffB[2];
#pragma unroll
    for (int i = 0; i < 2; ++i) { int R, C; stage_rc(tid * 16 + i * 8192, R, C); const int Rb = Epi::PERM ? ((R & ~31) + perm32(R & 31)) : R;
        voffA[i] = (unsigned)(R * BK + C) * 2u; voffB[i] = (unsigned)(Rb * BK + C) * 2u; }
    const size_t kstep = (size_t)BM * BK * 2, kstepB = kstep;
    const size_t hsA = (size_t)HALF * BK * 2, hsB = hsA;
    const size_t tsA = (size_t)g.lda * kstep, tsB = (size_t)nt * kstepB;
    const unsigned ldsw = (unsigned)wid * 1024u;
    const int aoff = lds_byte(wr * 64 + fr, fq * 8), boff = lds_byte(wc * 32 + fr, fq * 8);
#define PG8_SA(b, h) (((b) * 2 + (h)) * HTB)
#define PG8_SB(b, h) ((4 + (b) * 2 + (h)) * HTB)
#define PG8_STAGE(bufoff, gbase, voff) do { _Pragma("unroll") for (int _i = 0; _i < 2; ++_i) \
        __builtin_amdgcn_global_load_lds((const unsigned*)((const char*)(gbase) + (voff)[_i]), (PG8_LAS unsigned*)(lds + (bufoff) + ldsw + _i * 8192), 16, 0, 0); } while (0)
#define PG8_LDA(dst, b, h) do { _Pragma("unroll") for (int m = 0; m < 4; ++m) _Pragma("unroll") for (int k = 0; k < 2; ++k) dst[m][k] = *(const PG8_LAS bf16x8*)(lds + PG8_SA(b, h) + aoff + m * 2048 + k * 1024); } while (0)
#define PG8_LDB(dst, b, h) do { _Pragma("unroll") for (int n = 0; n < 2; ++n) _Pragma("unroll") for (int k = 0; k < 2; ++k) dst[n][k] = *(const PG8_LAS bf16x8*)(lds + PG8_SB(b, h) + boff + n * 2048 + k * 1024); } while (0)
#define PG8_MMA(ai, bj, At, Bt) do { __builtin_amdgcn_s_setprio(1); _Pragma("unroll") for (int m = 0; m < 4; ++m) _Pragma("unroll") for (int n = 0; n < 2; ++n) _Pragma("unroll") for (int k = 0; k < 2; ++k) \
        acc[ai][bj][m][n] = __builtin_amdgcn_mfma_f32_16x16x32_bf16(Bt[n][k], At[m][k], acc[ai][bj][m][n], 0, 0, 0); __builtin_amdgcn_s_setprio(0); } while (0)
#define PG8_WAIT_V(n) asm volatile("s_waitcnt vmcnt(" #n ")" ::: "memory")
#define PG8_WAIT_L(n) asm volatile("s_waitcnt lgkmcnt(" #n ")" ::: "memory")
#define PG8_BAR __builtin_amdgcn_s_barrier()
#define PG8_SCHED __builtin_amdgcn_sched_barrier(0)
    Unit cur, nxt; int ui = 0;
    if (!S.next(0, cur)) return;
    f32x4 acc[2][2][4][2];
#pragma unroll
    for (int a = 0; a < 2; ++a)
#pragma unroll
        for (int b = 0; b < 2; ++b)
#pragma unroll
            for (int m = 0; m < 4; ++m)
#pragma unroll
                for (int n = 0; n < 2; ++n) acc[a][b][m][n] = (f32x4){0.f, 0.f, 0.f, 0.f};
    bf16x8 At[4][2], B0[2][2], B1[2][2];
    const char* cA = (const char*)g.A + (size_t)cur.pm * tsA; const char* cB = (const char*)g.Bt + (size_t)cur.pn * tsB;
    S.a_ready(cur);
    if constexpr (SP2) {
        PG8_STAGE(PG8_SB(0, 0), cB, voffB); PG8_STAGE(PG8_SB(0, 1), cB + hsB, voffB); PG8_STAGE(PG8_SA(0, 0), cA, voffA); PG8_STAGE(PG8_SA(0, 1), cA + hsA, voffA);
        if (wr == 1) PG8_BAR;
        PG8_WAIT_V(2); PG8_BAR;
        PG8_STAGE(PG8_SB(1, 0), cB + kstepB, voffB); PG8_STAGE(PG8_SA(1, 0), cA + kstep, voffA); PG8_STAGE(PG8_SB(1, 1), cB + hsB + kstepB, voffB);
        PG8_WAIT_V(6); PG8_BAR;
    } else {
        PG8_STAGE(PG8_SB(0, 0), cB, voffB); PG8_STAGE(PG8_SA(0, 0), cA, voffA); PG8_STAGE(PG8_SB(0, 1), cB + hsB, voffB); PG8_STAGE(PG8_SA(0, 1), cA + hsA, voffA);
        if (wr == 1) PG8_BAR;
        PG8_WAIT_V(4); PG8_BAR;
        PG8_STAGE(PG8_SB(1, 0), cB + kstepB, voffB); PG8_STAGE(PG8_SA(1, 0), cA + kstep, voffA); PG8_STAGE(PG8_SB(1, 1), cB + hsB + kstepB, voffB);
        PG8_WAIT_V(6); PG8_BAR;
    }
    for (;;) {
        const bool has_next = S.next(ui + 1, nxt);
        const char* nA = has_next ? (const char*)g.A + (size_t)nxt.pm * tsA : cA; const char* nB = has_next ? (const char*)g.Bt + (size_t)nxt.pn * tsB : cB;
#pragma nounroll
        for (int t = 0; t < nt; t += 2) {
            const bool last = (t == nt - 2);
            const char* a1 = cA + (size_t)(t + 1) * kstep;
            const char* a2 = last ? nA : cA + (size_t)(t + 2) * kstep; const char* b2 = last ? nB : cB + (size_t)(t + 2) * kstepB;
            const char* a3 = a2 + kstep; const char* b3 = b2 + kstepB;
            if (last && has_next) S.a_ready(nxt);
            if constexpr (SP2) {
            PG8_LDB(B0, 0, 0); PG8_LDB(B1, 0, 1); PG8_SCHED; PG8_LDA(At, 0, 0); PG8_STAGE(PG8_SA(1, 1), a1 + hsA, voffA);
            PG8_WAIT_V(8); PG8_WAIT_L(0); PG8_BAR; PG8_MMA(0, 0, At, B0); PG8_MMA(0, 1, At, B1); PG8_BAR; PG8_SCHED;
            PG8_LDA(At, 0, 1); PG8_STAGE(PG8_SB(0, 0), b2, voffB); PG8_STAGE(PG8_SB(0, 1), b2 + hsB, voffB); PG8_STAGE(PG8_SA(0, 0), a2, voffA);
            PG8_WAIT_V(8); PG8_WAIT_L(0); PG8_BAR; PG8_MMA(1, 0, At, B0); PG8_MMA(1, 1, At, B1); PG8_BAR; PG8_SCHED;
            PG8_LDB(B0, 1, 0); PG8_LDB(B1, 1, 1); PG8_SCHED; PG8_LDA(At, 1, 0); PG8_STAGE(PG8_SA(0, 1), a2 + hsA, voffA);
            PG8_WAIT_V(8); PG8_WAIT_L(0); PG8_BAR; PG8_MMA(0, 0, At, B0); PG8_MMA(0, 1, At, B1); PG8_BAR; PG8_SCHED;
            PG8_LDA(At, 1, 1); PG8_STAGE(PG8_SB(1, 0), b3, voffB); PG8_STAGE(PG8_SB(1, 1), b3 + hsB, voffB); PG8_STAGE(PG8_SA(1, 0), a3, voffA);
            PG8_WAIT_V(8); PG8_WAIT_L(0); PG8_BAR; PG8_MMA(1, 0, At, B0); PG8_MMA(1, 1, At, B1); PG8_BAR; PG8_SCHED;
            } else {
            PG8_LDB(B0, 0, 0); PG8_SCHED; PG8_LDA(At, 0, 0); PG8_STAGE(PG8_SA(1, 1), a1 + hsA, voffA);
            PG8_WAIT_L(8); PG8_BAR; PG8_WAIT_L(0); PG8_MMA(0, 0, At, B0); PG8_BAR; PG8_SCHED;
            PG8_LDB(B1, 0, 1); PG8_STAGE(PG8_SB(0, 0), b2, voffB);
            PG8_BAR; PG8_WAIT_L(0); PG8_MMA(0, 1, At, B1); PG8_BAR;
            PG8_LDA(At, 0, 1); PG8_STAGE(PG8_SA(0, 0), a2, voffA);
            PG8_BAR; PG8_WAIT_L(0); PG8_MMA(1, 0, At, B0); PG8_BAR; PG8_SCHED;
            PG8_STAGE(PG8_SB(0, 1), b2 + hsB, voffB);
            PG8_WAIT_V(6); PG8_BAR; PG8_MMA(1, 1, At, B1); PG8_BAR;
            PG8_LDB(B0, 1, 0); PG8_SCHED; PG8_LDA(At, 1, 0); PG8_STAGE(PG8_SA(0, 1), a2 + hsA, voffA);
            PG8_WAIT_L(8); PG8_BAR; PG8_WAIT_L(0); PG8_MMA(0, 0, At, B0); PG8_BAR; PG8_SCHED;
            PG8_LDB(B1, 1, 1); PG8_STAGE(PG8_SB(1, 0), b3, voffB);
            PG8_BAR; PG8_WAIT_L(0); PG8_MMA(0, 1, At, B1); PG8_BAR;
            PG8_LDA(At, 1, 1); PG8_STAGE(PG8_SA(1, 0), a3, voffA);
            PG8_BAR; PG8_WAIT_L(0); PG8_MMA(1, 0, At, B0); PG8_BAR; PG8_SCHED;
            PG8_STAGE(PG8_SB(1, 1), b3 + hsB, voffB);
            PG8_WAIT_V(6); PG8_BAR; PG8_MMA(1, 1, At, B1); PG8_BAR;
            }
        }
        if constexpr (ALIGN_EPI) { if (wr == 0) PG8_BAR; }
        if constexpr (!Epi::AFTER_DRAIN) { E(acc, cur, wr, wc, fr, fq); S.done(cur); }
        if (!has_next) break;
#pragma unroll
        for (int a = 0; a < 2; ++a)
#pragma unroll
            for (int b = 0; b < 2; ++b)
#pragma unroll
                for (int m = 0; m < 4; ++m)
#pragma unroll
                    for (int n = 0; n < 2; ++n) acc[a][b][m][n] = (f32x4){0.f, 0.f, 0.f, 0.f};
        cur = nxt; cA = nA; cB = nB; ++ui;
        if constexpr (ALIGN_EPI) { if (wr == 1) PG8_BAR; }
    }
    PG8_WAIT_V(0);
    if constexpr (!ALIGN_EPI) { if (wr == 0) PG8_BAR; }
    PG8_BAR;
#undef PG8_SA
#undef PG8_SB
#undef PG8_STAGE
#undef PG8_LDA
#undef PG8_LDB
#undef PG8_MMA
#undef PG8_WAIT_V
#undef PG8_WAIT_L
#undef PG8_BAR
#undef PG8_SCHED
}
}

#ifndef PG8_SP2
#define PG8_SP2 true
#endif
#ifndef PG8_ALIGN
#define PG8_ALIGN true
#endif

constexpr int NWAVES = 8;
#ifndef MK_N_LAUNCHES
#define MK_N_LAUNCHES 1
#endif
constexpr int NPH = 15;
constexpr bool ONE_LAUNCH = (MK_N_LAUNCHES == 1);

constexpr int BATCH = 2, SEQ = 8192, D = 4096, M = BATCH * SEQ;
constexpr int HW = 2048, NH = 16, HD = 128, NKV = 4, DFF = 16384, PLE = 256;
constexpr int NIN = 21504;
constexpr int NP2 = 10240, C2_HG = 0, C2_GA = 2048, C2_GB = 6144;
constexpr float EPS = 1e-6f;

constexpr size_t MiB = 1u << 20;
constexpr size_t WS_CTL = 0, CTL_ZERO_BYTES = 1 * MiB;
constexpr size_t WS_LB = 1 * MiB;
constexpr size_t WS_ROPE = 2 * MiB;
constexpr size_t WS_SS = 6 * MiB;
constexpr size_t WS_PBF = 10 * MiB;
constexpr size_t WS_WIN = 18 * MiB;
constexpr size_t WS_WHP = 186 * MiB, WS_WAP = 202 * MiB, WS_WOUT = 218 * MiB, WS_WUP = 250 * MiB, WS_WDN = 378 * MiB, WS_WPLE = 506 * MiB, WS_WPG = 508 * MiB;
constexpr size_t WS_XN = 540 * MiB;
constexpr size_t WS_PROJ = 668 * MiB;
constexpr size_t WS_SQ = WS_PROJ, WS_SFF = WS_PROJ + 64 * MiB, WS_SFB = WS_PROJ + 128 * MiB, WS_SV = WS_PROJ + 192 * MiB;
constexpr size_t WS_ATQ = WS_PROJ + 256 * MiB, WS_ATK = WS_PROJ + 320 * MiB, WS_ATV = WS_PROJ + 336 * MiB, WS_P2 = WS_PROJ + 352 * MiB;
constexpr size_t WS_END = 1340 * MiB;
constexpr size_t WS_OF = WS_WIN, WS_OB = WS_WIN + 64 * MiB, WS_MIX = WS_WIN;
constexpr size_t WS_Y = WS_PROJ;
constexpr size_t WS_SEND = 146 * MiB, WS_DTOT = 162 * MiB;
constexpr size_t WS_U = WS_PROJ, WS_E = WS_PROJ, WS_V = WS_PROJ + 128 * MiB;
constexpr int CW_TMO = 0, CW_CODE = 1;
constexpr int CW_BAR = 4096;

constexpr int RING_OFF = 0, RING_BYTES = 131072;
constexpr int LDSCTL_OFF = RING_BYTES, MISC_OFF = LDSCTL_OFF + 320;
constexpr int LDS_BYTES = 147456;

#define GAS __attribute__((address_space(1)))
#define LAS __attribute__((address_space(3)))
typedef unsigned short bf16;
typedef unsigned v4u __attribute__((ext_vector_type(4)));
typedef unsigned v2u __attribute__((ext_vector_type(2)));
typedef float f32x4 __attribute__((ext_vector_type(4)));
typedef float f32x2 __attribute__((ext_vector_type(2)));
typedef GAS unsigned gu32;
#define RLX_AGENT __ATOMIC_RELAXED, __HIP_MEMORY_SCOPE_AGENT
#define LDS_WAIT() asm volatile("s_waitcnt lgkmcnt(0)" ::: "memory")
#define VM_WAIT() asm volatile("s_waitcnt vmcnt(0)" ::: "memory")
__device__ __forceinline__ size_t tiled_off(int r, int k, int Kt) { return ((size_t)((r >> 8) * (Kt >> 6) + (k >> 6)) * 256 + (r & 255)) * 64 + (k & 63); }
__device__ __forceinline__ unsigned f2bf(float f) { unsigned u = __builtin_bit_cast(unsigned, f); return (u + 0x7fffu + ((u >> 16) & 1u)) >> 16; }
__device__ __forceinline__ unsigned pk2(float lo, float hi) { return f2bf(lo) | (f2bf(hi) << 16); }
__device__ __forceinline__ float bf2f(bf16 b) { return __uint_as_float((unsigned)b << 16); }
__device__ __forceinline__ float blo(unsigned w) { return __uint_as_float(w << 16); }
__device__ __forceinline__ float bhi(unsigned w) { return __uint_as_float(w & 0xffff0000u); }

#define XB_TMO      128
#define XB_XCNT(j)  (256  + 64 * (j))
#define XB_XSUB(j)  (1280 + 64 * (j))
#define XB_XGEN(j)  (2304 + 64 * (j))
#define XB_TOP      3328
#define XB_TOPGEN   3392
#define XCD_BAR_WORDS 3456
#define XB_SPIN_CAP (1u << 18)

__device__ __forceinline__ unsigned xb_ld(unsigned* p)              { return __hip_atomic_load(p, __ATOMIC_RELAXED, __HIP_MEMORY_SCOPE_AGENT); }
__device__ __forceinline__ unsigned xb_add(unsigned* p, unsigned v) { return __hip_atomic_fetch_add(p, v, __ATOMIC_RELAXED, __HIP_MEMORY_SCOPE_AGENT); }
__device__ __forceinline__ unsigned xb_xcc_id() { return (unsigned)__builtin_amdgcn_s_getreg((3 << 11) | 20) & 0xFu; }
#define XB_SPIN(cond, bar) do { unsigned _sp = 0; while (cond) { __builtin_amdgcn_s_sleep(1); \
    if ((++_sp & 255u) == 0u) { if (xb_ld(&(bar)[XB_TMO])) break; if (_sp > XB_SPIN_CAP) { atomicAdd(&(bar)[XB_TMO], 1u); break; } } } } while (0)

struct XcdBarrier { unsigned* bar; unsigned x; volatile LAS unsigned* st; };

__device__ __forceinline__ XcdBarrier xcd_barrier_post(unsigned* bar, volatile LAS unsigned* st) {
    XcdBarrier b; b.bar = bar; b.x = xb_xcc_id(); b.st = st;
    if (threadIdx.x == 0) (void)xb_add(&bar[XB_XCNT(b.x)], 1u);
    return b;
}
__device__ __forceinline__ void xcd_barrier_complete(unsigned* bar, unsigned x, unsigned& nloc, unsigned& nx) {
    const unsigned G = gridDim.x * gridDim.y * gridDim.z;
    unsigned sum, cnt, mine, sp = 0u;
    for (;;) {
        sum = 0u; cnt = 0u; mine = 0u;
#pragma unroll
        for (unsigned j = 0; j < 16; ++j) { const unsigned c = xb_ld(&bar[XB_XCNT(j)]); sum += c; cnt += (c > 0u) ? 1u : 0u; mine = (j == x) ? c : mine; }
        if (sum == G) break;
        __builtin_amdgcn_s_sleep(1);
        if ((++sp & 255u) == 0u) { if (xb_ld(&bar[XB_TMO])) break; if (sp > XB_SPIN_CAP) { atomicAdd(&bar[XB_TMO], 1u); break; } }
    }
    nloc = mine > 0u ? mine : 1u; nx = cnt > 0u ? cnt : 1u;
}
__device__ __forceinline__ void xcd_barrier(const XcdBarrier& b) {
    asm volatile("s_waitcnt vmcnt(0)" ::: "memory");
    __syncthreads();
    if (threadIdx.x == 0) {
        unsigned* bar = b.bar;
        __builtin_amdgcn_s_waitcnt(0);
        unsigned nloc = b.st[0], nx = b.st[1];
        if (nloc == 0u) { xcd_barrier_complete(bar, b.x, nloc, nx); b.st[0] = nloc; b.st[1] = nx; }
        const unsigned old = xb_add(&bar[XB_XSUB(b.x)], 1u);
        const unsigned gen = old / nloc;
        if (old + 1u == (gen + 1u) * nloc) {
            __builtin_amdgcn_fence(__ATOMIC_RELEASE, "agent");
            asm volatile("s_waitcnt vmcnt(0)" ::: "memory");
            const unsigned og = xb_add(&bar[XB_TOP], 1u);
            const unsigned tg = og / nx;
            if (og + 1u == (tg + 1u) * nx) xb_add(&bar[XB_TOPGEN], 1u);
            else XB_SPIN(xb_ld(&bar[XB_TOPGEN]) == tg, bar);
            __builtin_amdgcn_fence(__ATOMIC_ACQUIRE, "agent");
            xb_add(&bar[XB_XGEN(b.x)], 1u);
            asm volatile("s_waitcnt vmcnt(0)" ::: "memory");
        } else {
            XB_SPIN(xb_ld(&bar[XB_XGEN(b.x)]) == gen, bar);
            __builtin_amdgcn_fence(__ATOMIC_ACQUIRE, "agent");
            asm volatile("s_waitcnt vmcnt(0)" ::: "memory");
        }
    }
    __syncthreads();
}

#define KIN(i) (((const float* const __attribute__((address_space(4)))*)__builtin_amdgcn_kernarg_segment_ptr())[i])
struct Frame {
    LAS unsigned char* lds;
    volatile LAS unsigned* MISC;
    gu32* ctl;
    int tid, lane, wave;
    int vcu, G;
    float* out;
    unsigned char* ws;
};
__device__ __forceinline__ float wave_sum(float v) {
#pragma unroll
    for (int o = 1; o < 64; o <<= 1) v += __shfl_xor(v, o);
    return v;
}
__device__ __forceinline__ float wave_max(float v) {
#pragma unroll
    for (int o = 1; o < 64; o <<= 1) v = fmaxf(v, __shfl_xor(v, o));
    return v;
}

__device__ const double INV_FREQ[64] = {
1.0, 0.8659643233600653, 0.7498942093324559, 0.6493816315762113, 0.5623413251903491, 0.4869675251658631, 0.4216965034285822, 0.3651741272548377, 0.31622776601683794, 0.27384196342643613, 0.23713737056616552, 0.2053525026457146, 0.1778279410038923, 0.1539926526059492, 0.1333521432163324, 0.11547819846894582, 0.1, 0.08659643233600653, 0.07498942093324558, 0.06493816315762113, 0.05623413251903491, 0.04869675251658631, 0.042169650342858224, 0.03651741272548377, 0.03162277660168379, 0.027384196342643614, 0.023713737056616554, 0.02053525026457146, 0.01778279410038923, 0.01539926526059492, 0.01333521432163324, 0.011547819846894581, 0.01, 0.008659643233600654, 0.007498942093324558, 0.006493816315762113, 0.005623413251903491, 0.004869675251658631, 0.004216965034285823, 0.003651741272548377, 0.0031622776601683794, 0.0027384196342643613, 0.0023713737056616554, 0.002053525026457146, 0.0017782794100389228, 0.001539926526059492, 0.001333521432163324, 0.0011547819846894581, 0.001, 0.0008659643233600654, 0.0007498942093324559, 0.0006493816315762113, 0.0005623413251903491, 0.0004869675251658631, 0.00042169650342858224, 0.0003651741272548377, 0.00031622776601683794, 0.0002738419634264361, 0.00023713737056616554, 0.0002053525026457146, 0.00017782794100389227, 0.0001539926526059492, 0.0001333521432163324, 0.00011547819846894582};

__device__ __forceinline__ void p0_transpose_item(const float* W, int K, int N, bf16* WT, LAS float* scr, int item, int lane) {
    const int nblk = N / 32, kb = item / nblk, nb = item % nblk, k0 = 64 * kb, n0 = 32 * nb;
    f32x4 v[8];
#pragma unroll
    for (int i = 0; i < 8; ++i) v[i] = *(const GAS f32x4*)(W + (size_t)(k0 + (lane >> 3) + 8 * i) * N + n0 + 4 * (lane & 7));
#pragma unroll
    for (int i = 0; i < 8; ++i) { const int kk = (lane >> 3) + 8 * i; LAS float* d = scr + (4 * (lane & 7)) * 68 + kk; d[0] = v[i].x; d[68] = v[i].y; d[2 * 68] = v[i].z; d[3 * 68] = v[i].w; }
    LDS_WAIT(); asm volatile("" ::: "memory");
    const int c = lane & 7;
#pragma unroll
    for (int j = 0; j < 4; ++j) { const int n = (lane >> 3) + 8 * j; const LAS f32x4* s = (const LAS f32x4*)(scr + n * 68 + 8 * c); const f32x4 a = s[0], bq = s[1];
        v4u o; o.x = pk2(a.x, a.y); o.y = pk2(a.z, a.w); o.z = pk2(bq.x, bq.y); o.w = pk2(bq.z, bq.w);
        const int nn = n0 + n, kg = k0 + 8 * c;
        *(GAS v4u*)(WT + ((size_t)((nn >> 8) * (K >> 6) + (kg >> 6)) * 256 + (nn & 255)) * 64 + (kg & 63)) = o; }
    LDS_WAIT(); asm volatile("" ::: "memory");
}
__device__ __forceinline__ void rms_row_to_bf16(int lane, const float* xrow, const float* w, bf16* orow, int m) {
    const GAS f32x4* xr = (const GAS f32x4*)xrow + lane;
    f32x4 v[16]; float s = 0.f;
#pragma unroll
    for (int j = 0; j < 16; ++j) { v[j] = xr[64 * j]; s += (v[j].x * v[j].x + v[j].y * v[j].y) + (v[j].z * v[j].z + v[j].w * v[j].w); }
    const float rstd = 1.f / sqrtf(wave_sum(s) * (1.f / D) + EPS);
    const GAS f32x4* wr = (const GAS f32x4*)w + lane;
#pragma unroll
    for (int j = 0; j < 16; ++j) { const f32x4 g = wr[64 * j]; v2u o; o.x = pk2(v[j].x * rstd * g.x, v[j].y * rstd * g.y); o.y = pk2(v[j].z * rstd * g.z, v[j].w * rstd * g.w);
        *(GAS v2u*)(orow + tiled_off(m, 4 * lane + 256 * j, D)) = o; }
}

__device__ __forceinline__ void p0_prologue(Frame& F) {
    LAS float* scr = (LAS float*)(F.lds + RING_OFF + F.wave * 16384);
    const int gw = F.vcu * NWAVES + F.wave, NGW = F.G * NWAVES;
    constexpr int I_IN = (D / 64) * (NIN / 32), I_HP = (HW / 64) * (D / 32), I_AP = I_HP, I_OUT = (D / 64) * (D / 32), I_UP = (D / 64) * (DFF / 32), I_DN = (DFF / 64) * (D / 32), I_PLE = (PLE / 64) * (D / 32), I_PG = I_OUT;
    constexpr int NITEMS = I_IN + I_HP + I_AP + I_OUT + I_UP + I_DN + I_PLE + I_PG;
    unsigned char* ws = F.ws;
    for (int it = gw; it < NITEMS; it += NGW) {
        int r = it;
        if (r < I_IN) { p0_transpose_item(KIN(4), D, NIN, (bf16*)(ws + WS_WIN), scr, r, F.lane); continue; } r -= I_IN;
        if (r < I_HP) { p0_transpose_item(KIN(9), HW, D, (bf16*)(ws + WS_WHP), scr, r, F.lane); continue; } r -= I_HP;
        if (r < I_AP) { p0_transpose_item(KIN(10), HW, D, (bf16*)(ws + WS_WAP), scr, r, F.lane); continue; } r -= I_AP;
        if (r < I_OUT) { p0_transpose_item(KIN(11), D, D, (bf16*)(ws + WS_WOUT), scr, r, F.lane); continue; } r -= I_OUT;
        if (r < I_UP) { p0_transpose_item(KIN(14), D, DFF, (bf16*)(ws + WS_WUP), scr, r, F.lane); continue; } r -= I_UP;
        if (r < I_DN) { p0_transpose_item(KIN(15), DFF, D, (bf16*)(ws + WS_WDN), scr, r, F.lane); continue; } r -= I_DN;
        if (r < I_PLE) { p0_transpose_item(KIN(16), PLE, D, (bf16*)(ws + WS_WPLE), scr, r, F.lane); continue; } r -= I_PLE;
        p0_transpose_item(KIN(17), D, D, (bf16*)(ws + WS_WPG), scr, r, F.lane);
    }
    for (int m = gw; m < M; m += NGW) rms_row_to_bf16(F.lane, KIN(0) + (size_t)m * D, KIN(2), (bf16*)(ws + WS_XN), m);
    { const GAS f32x4* p4 = (const GAS f32x4*)KIN(1); GAS v2u* o = (GAS v2u*)(ws + WS_PBF);
      for (size_t i = (size_t)gw * 64 + F.lane; i < (size_t)M * PLE / 4; i += (size_t)NGW * 64) { const f32x4 v = p4[i]; v2u w; w.x = pk2(v.x, v.y); w.y = pk2(v.z, v.w);
          *(GAS v2u*)((bf16*)o + tiled_off((int)(i >> 6), (int)(i & 63) * 4, PLE)) = w; } }
    { float* ct = (float*)(ws + WS_ROPE); float* st = ct + SEQ * 64;
      for (int i = gw * 64 + F.lane; i < SEQ * 64; i += NGW * 64) {
          const int pos = i >> 6, fi = i & 63;
          const double x = (double)pos * INV_FREQ[fi];
          const double k = __builtin_rint(x * 0.63661977236758134308);
          double r = __builtin_fma(-k, 1.57079632679489655800e+00, x); r = __builtin_fma(-k, 6.12323399573676603587e-17, r);
          const double r2 = r * r;
          double sp = -1.0 / 1307674368000.0; sp = sp * r2 + 1.0 / 6227020800.0; sp = sp * r2 - 1.0 / 39916800.0; sp = sp * r2 + 1.0 / 362880.0; sp = sp * r2 - 1.0 / 5040.0; sp = sp * r2 + 1.0 / 120.0; sp = sp * r2 - 1.0 / 6.0; sp = sp * r2 + 1.0;
          const double sn = sp * r;
          double cp = 1.0 / 20922789888000.0; cp = cp * r2 - 1.0 / 87178291200.0; cp = cp * r2 + 1.0 / 479001600.0; cp = cp * r2 - 1.0 / 3628800.0; cp = cp * r2 + 1.0 / 40320.0; cp = cp * r2 - 1.0 / 720.0; cp = cp * r2 + 1.0 / 24.0; cp = cp * r2 - 0.5; cp = cp * r2 + 1.0;
          const int q = (int)((long long)k & 3);
          const double cs = (q == 0) ? cp : (q == 1) ? -sn : (q == 2) ? -cp : sn;
          const double ss = (q == 0) ? sn : (q == 1) ? cp : (q == 2) ? -sn : -cp;
          ct[i] = (float)cs; st[i] = (float)ss;
      } }
    { float* lbf = (float*)(ws + WS_LB); float* lbb = lbf + HW;
      for (int i = gw * 64 + F.lane; i < 2 * HW; i += NGW * 64) {
          const float* src = (i < HW) ? KIN(5) : KIN(6); const int c = (i < HW) ? i : i - HW;
          const float a = src[c], b = src[HW + c];
          const float l = 1.f / (1.f + expf(b - a));
          if (i < HW) lbf[c] = l; else lbb[c] = l;
      } }
}

namespace att {
typedef float f32x16 __attribute__((ext_vector_type(16)));
typedef short bf16x8 __attribute__((ext_vector_type(8)));
typedef short s16x4 __attribute__((ext_vector_type(4)));
typedef short v4i16_t __attribute__((ext_vector_type(4)));
constexpr int KST = 272, VST = 320;
constexpr int KBYTES = 64 * KST, VBYTES = 64 * VST, BUFB = KBYTES + VBYTES;
constexpr float SCL = 0.08838834764831845f * 1.4426950408889634f;
__device__ __forceinline__ s16x4 vtr(const LAS unsigned char* p) { return __builtin_bit_cast(s16x4, __builtin_amdgcn_ds_read_tr16_b64_v4i16((LAS v4i16_t*)p)); }
__device__ __forceinline__ bf16x8 pack8(const float* v) { v4u r; r.x = pg8::cvt_pk_bf16(v[0], v[1]); r.y = pg8::cvt_pk_bf16(v[2], v[3]); r.z = pg8::cvt_pk_bf16(v[4], v[5]); r.w = pg8::cvt_pk_bf16(v[6], v[7]); return __builtin_bit_cast(bf16x8, r); }
struct Pre { v4u k1, k2, v1, v2; f32x4 c0, c1, s0, s1; };
__device__ __forceinline__ void load_tile(Pre& P, const bf16* proj, const float* ct, const float* st, int b, int kvh, int j0, int tid) {
    const int key = tid >> 3, cp = tid & 7, j = j0 + key;
    const size_t ro = ((size_t)(b * NKV + kvh) * SEQ + j) * 128 + 8 * cp;
    const bf16* kr = proj + (WS_ATK - WS_PROJ) / 2 + ro; const bf16* vr = proj + (WS_ATV - WS_PROJ) / 2 + ro;
    P.k1 = *(const GAS v4u*)(kr); P.k2 = *(const GAS v4u*)(kr + 64);
    P.v1 = *(const GAS v4u*)(vr); P.v2 = *(const GAS v4u*)(vr + 64);
    P.c0 = *(const GAS f32x4*)(ct + j * 64 + 8 * cp); P.c1 = *(const GAS f32x4*)(ct + j * 64 + 8 * cp + 4);
    P.s0 = *(const GAS f32x4*)(st + j * 64 + 8 * cp); P.s1 = *(const GAS f32x4*)(st + j * 64 + 8 * cp + 4);
}
__device__ __forceinline__ void rot8(v4u a, v4u b, f32x4 c0, f32x4 c1, f32x4 s0, f32x4 s1, v4u& y1, v4u& y2) {
    const float x1[8] = {blo(a.x), bhi(a.x), blo(a.y), bhi(a.y), blo(a.z), bhi(a.z), blo(a.w), bhi(a.w)};
    const float x2[8] = {blo(b.x), bhi(b.x), blo(b.y), bhi(b.y), blo(b.z), bhi(b.z), blo(b.w), bhi(b.w)};
    const float c[8] = {c0.x, c0.y, c0.z, c0.w, c1.x, c1.y, c1.z, c1.w}, s[8] = {s0.x, s0.y, s0.z, s0.w, s1.x, s1.y, s1.z, s1.w};
    float r1[8], r2[8];
#pragma unroll
    for (int j = 0; j < 8; ++j) { r1[j] = x1[j] * c[j] - x2[j] * s[j]; r2[j] = x2[j] * c[j] + x1[j] * s[j]; }
    y1.x = pg8::cvt_pk_bf16(r1[0], r1[1]); y1.y = pg8::cvt_pk_bf16(r1[2], r1[3]); y1.z = pg8::cvt_pk_bf16(r1[4], r1[5]); y1.w = pg8::cvt_pk_bf16(r1[6], r1[7]);
    y2.x = pg8::cvt_pk_bf16(r2[0], r2[1]); y2.y = pg8::cvt_pk_bf16(r2[2], r2[3]); y2.z = pg8::cvt_pk_bf16(r2[4], r2[5]); y2.w = pg8::cvt_pk_bf16(r2[6], r2[7]);
}
__device__ __forceinline__ void store_tile(const Pre& P, LAS unsigned char* buf, int tid) {
    const int key = tid >> 3, cp = tid & 7;
    v4u y1, y2; rot8(P.k1, P.k2, P.c0, P.c1, P.s0, P.s1, y1, y2);
    *(LAS v4u*)(buf + key * KST + 16 * cp) = y1; *(LAS v4u*)(buf + key * KST + 128 + 16 * cp) = y2;
    *(LAS v4u*)(buf + KBYTES + key * VST + 16 * cp) = P.v1; *(LAS v4u*)(buf + KBYTES + key * VST + 128 + 16 * cp) = P.v2;
}
__device__ __forceinline__ void attn_unit(Frame& F, int u) {
    const int tid = F.tid, lane = F.lane, w = F.wave;
    const int qb = u & 127, kvh = (u >> 7) & 3, b = u >> 9;
    const int q0 = qb * 64, g = w >> 1, rh = w & 1, hh = kvh * 4 + g;
    const int ql = lane & 31, h = lane >> 5, rr = 32 * rh + ql, irow = q0 + rr;
    const bf16* proj = (const bf16*)(F.ws + WS_PROJ);
    const float* ct = (const float*)(F.ws + WS_ROPE); const float* st = ct + SEQ * 64;
    LAS unsigned char* lds = F.lds + RING_OFF;
    bf16x8 qf[8];
    { const bf16* qrow = proj + (WS_ATQ - WS_PROJ) / 2 + ((size_t)(b * NH + hh) * SEQ + irow) * 128;
#pragma unroll
      for (int ks = 0; ks < 4; ++ks) {
          const v4u a = *(const GAS v4u*)(qrow + 16 * ks + 8 * h), bb = *(const GAS v4u*)(qrow + 64 + 16 * ks + 8 * h);
          const float* cp_ = ct + irow * 64 + 16 * ks + 8 * h; const float* sp_ = st + irow * 64 + 16 * ks + 8 * h;
          v4u y1, y2; rot8(a, bb, *(const GAS f32x4*)cp_, *(const GAS f32x4*)(cp_ + 4), *(const GAS f32x4*)sp_, *(const GAS f32x4*)(sp_ + 4), y1, y2);
          qf[ks] = __builtin_bit_cast(bf16x8, y1); qf[ks + 4] = __builtin_bit_cast(bf16x8, y2);
      } }
    const float sinkL = KIN(8)[hh] * 1.4426950408889634f;
    float mrun = sinkL, lrun = (h == 0) ? 1.f : 0.f;
    f32x16 O[4];
#pragma unroll
    for (int dt = 0; dt < 4; ++dt)
#pragma unroll
        for (int r = 0; r < 16; ++r) O[dt][r] = 0.f;
    const int tlo = (q0 >= 128) ? 0 : ((q0 >= 64) ? 1 : 2), thi = (q0 + 192 <= SEQ) ? 4 : ((q0 + 128 <= SEQ) ? 3 : 2);
    Pre P;
    load_tile(P, proj, ct, st, b, kvh, q0 - 128 + 64 * tlo, tid);
    store_tile(P, lds + (tlo & 1) * BUFB, tid);
    __syncthreads();
    const int q4 = (lane & 15) >> 2, p4 = lane & 3, dblk = (lane >> 4) & 1;
    for (int t = tlo; t <= thi; ++t) {
        const LAS unsigned char* Kb = lds + (t & 1) * BUFB; const LAS unsigned char* Vb = Kb + KBYTES;
        if (t < thi) load_tile(P, proj, ct, st, b, kvh, q0 - 128 + 64 * (t + 1), tid);
        f32x16 sT[2];
#pragma unroll
        for (int kt = 0; kt < 2; ++kt) {
#pragma unroll
            for (int r = 0; r < 16; ++r) sT[kt][r] = 0.f;
#pragma unroll
            for (int ks = 0; ks < 8; ++ks) {
                const bf16x8 kf = *(const LAS bf16x8*)(Kb + (32 * kt + ql) * KST + (16 * ks + 8 * h) * 2);
                sT[kt] = __builtin_amdgcn_mfma_f32_32x32x16_bf16(kf, qf[ks], sT[kt], 0, 0, 0);
            }
        }
        float tmax = -INFINITY;
#pragma unroll
        for (int kt = 0; kt < 2; ++kt)
#pragma unroll
            for (int r = 0; r < 16; ++r) {
                const int kk = 32 * kt + (r & 3) + 8 * (r >> 2) + 4 * h;
                float v = sT[kt][r] * SCL;
                if (t == 0 && kk < rr) v = -INFINITY;
                if (t == 4 && kk > rr) v = -INFINITY;
                sT[kt][r] = v; tmax = fmaxf(tmax, v);
            }
        tmax = fmaxf(tmax, __shfl_xor(tmax, 32));
        const float mnew = fmaxf(mrun, tmax), alpha = __builtin_amdgcn_exp2f(mrun - mnew);
        mrun = mnew; lrun *= alpha;
        if (!__all(alpha == 1.f)) {
#pragma unroll
            for (int dt = 0; dt < 4; ++dt)
#pragma unroll
                for (int r = 0; r < 16; ++r) O[dt][r] *= alpha;
        }
        bf16x8 pf[2][2];
#pragma unroll
        for (int kt = 0; kt < 2; ++kt) {
            float pv[16];
#pragma unroll
            for (int r = 0; r < 16; ++r) { pv[r] = __builtin_amdgcn_exp2f(sT[kt][r] - mnew); lrun += pv[r]; }
            pf[kt][0] = pack8(pv); pf[kt][1] = pack8(pv + 8);
        }
#pragma unroll
        for (int dt = 0; dt < 4; ++dt)
#pragma unroll
            for (int kt = 0; kt < 2; ++kt)
#pragma unroll
                for (int s2 = 0; s2 < 2; ++s2) {
                    const LAS unsigned char* a = Vb + (32 * kt + 16 * s2 + 4 * h + q4) * VST + (32 * dt + 16 * dblk + 4 * p4) * 2;
                    const s16x4 lo = vtr(a), hi = vtr(a + 8 * VST);
                    const bf16x8 vf = __builtin_shufflevector(lo, hi, 0, 1, 2, 3, 4, 5, 6, 7);
                    O[dt] = __builtin_amdgcn_mfma_f32_32x32x16_bf16(vf, pf[kt][s2], O[dt], 0, 0, 0);
                }
        if (t < thi) store_tile(P, lds + ((t + 1) & 1) * BUFB, tid);
        __syncthreads();
    }
    const float ltot = lrun + __shfl_xor(lrun, 32), inv = 1.f / ltot;
    bf16* xnb = (bf16*)(F.ws + WS_XN); const int orow_m = b * SEQ + irow, ocol0 = HW + hh * 128;
#pragma unroll
    for (int dt = 0; dt < 4; ++dt)
#pragma unroll
        for (int rg = 0; rg < 4; ++rg) {
            v2u o; o.x = pg8::cvt_pk_bf16(O[dt][4 * rg] * inv, O[dt][4 * rg + 1] * inv); o.y = pg8::cvt_pk_bf16(O[dt][4 * rg + 2] * inv, O[dt][4 * rg + 3] * inv);
            *(GAS v2u*)(xnb + tiled_off(orow_m, ocol0 + 32 * dt + 8 * rg + 4 * h, D)) = o;
        }
}
}

namespace scn {
using att::f32x16; using att::bf16x8; using att::s16x4; using att::vtr; using att::pack8;
constexpr int QST = 272, TST = 320;
constexpr int QH_OFF = 0, KH_OFF = 64 * QST, KT_OFF = KH_OFF + 64 * QST, VV_OFF = KT_OFF + 64 * TST, ST_OFF = VV_OFF + 64 * TST, DEC_OFF = ST_OFF + 128 * QST, TOT_OFF = DEC_OFF + 512, FLAG_OFF = TOT_OFF + 8 * 128 * 4, END_OFF = FLAG_OFF + 16;
static_assert(END_OFF <= RING_BYTES, "scan LDS map");
struct Raw { v4u q1, q2, s1, s2, v1, v2; };
__device__ __forceinline__ void load_raw(Raw& R, const bf16* proj, int b, int h, int dir, int n, int tid) {
    const int i = tid >> 3, cp = tid & 7, tau = 64 * n + i, t = dir ? (SEQ - 1 - tau) : tau;
    const bf16* row = proj + ((size_t)(b * NH + h) * SEQ + t) * 128 + 8 * cp;
    const size_t C_HQ = (WS_SQ - WS_PROJ) / 2, C_HI = (WS_SV - WS_PROJ) / 2;
    const size_t cf = (dir ? (WS_SFB - WS_PROJ) : (WS_SFF - WS_PROJ)) / 2;
    R.q1 = *(const GAS v4u*)(row + C_HQ); R.q2 = *(const GAS v4u*)(row + C_HQ + 64);
    R.s1 = *(const GAS v4u*)(row + cf); R.s2 = *(const GAS v4u*)(row + cf + 64);
    R.v1 = *(const GAS v4u*)(row + C_HI); R.v2 = *(const GAS v4u*)(row + C_HI + 64);
}
__device__ __forceinline__ void store_raw(const Raw& R, LAS unsigned char* lds, int tid) {
    const int i = tid >> 3, cp = tid & 7;
    *(LAS v4u*)(lds + QH_OFF + i * QST + 16 * cp) = R.q1; *(LAS v4u*)(lds + QH_OFF + i * QST + 128 + 16 * cp) = R.q2;
    *(LAS v4u*)(lds + KH_OFF + i * QST + 16 * cp) = R.s1; *(LAS v4u*)(lds + KH_OFF + i * QST + 128 + 16 * cp) = R.s2;
    *(LAS v4u*)(lds + VV_OFF + i * TST + 16 * cp) = R.v1; *(LAS v4u*)(lds + VV_OFF + i * TST + 128 + 16 * cp) = R.v2;
}
struct Ctx { LAS unsigned char* lds; const bf16* proj; bf16* Og; int b, hd, dir, tid, ct, vt, ql, h, q4, p4, dblk, kp, sg, nend; float oml0, oml1; };
#define LBAR() do { asm volatile("s_waitcnt lgkmcnt(0)" ::: "memory"); __builtin_amdgcn_s_barrier(); asm volatile("" ::: "memory"); } while (0)
__device__ __forceinline__ void scan_step(const Ctx& C, f32x16 (&S)[2], float (&DT)[2], const Raw& Rst, Raw& Rld, const int n) {
    LAS unsigned char* lds = C.lds; const bf16* proj = C.proj; bf16* Og = C.Og;
    const int b = C.b, hd = C.hd, dir = C.dir, tid = C.tid, ct = C.ct, vt = C.vt, ql = C.ql, h = C.h, q4 = C.q4, p4 = C.p4, dblk = C.dblk, kp = C.kp, sg = C.sg;
    const float oml0 = C.oml0, oml1 = C.oml1;
        float qv0[8], qv1[8], kk0[8], kk1[8], pp0[8], pp1[8];
        { float run0 = 1.f, run1 = 1.f;
#pragma unroll
          for (int ii = 0; ii < 8; ++ii) {
              const int i = 8 * sg + ii;
              const unsigned qr = *(const LAS unsigned*)(lds + QH_OFF + i * QST + 4 * kp), sr = *(const LAS unsigned*)(lds + KH_OFF + i * QST + 4 * kp);
              qv0[ii] = blo(qr); qv1[ii] = bhi(qr);
              kk0[ii] = oml0 * blo(sr); kk1[ii] = oml1 * bhi(sr);
              run0 *= (1.f - kk0[ii]); run1 *= (1.f - kk1[ii]);
              pp0[ii] = run0; pp1[ii] = run1;
          }
          *(LAS f32x2*)(lds + TOT_OFF + (sg * 128 + 2 * kp) * 4) = (f32x2){run0, run1}; }
        LBAR();
        { float pre0 = 1.f, pre1 = 1.f, all0 = 1.f, all1 = 1.f;
#pragma unroll
          for (int s_ = 0; s_ < 8; ++s_) { const f32x2 T = *(const LAS f32x2*)(lds + TOT_OFF + (s_ * 128 + 2 * kp) * 4); all0 *= T.x; all1 *= T.y; if (s_ < sg) { pre0 *= T.x; pre1 *= T.y; } }
#pragma unroll
          for (int ii = 0; ii < 8; ++ii) {
              const int i = 8 * sg + ii;
              const float P0 = pre0 * pp0[ii], P1 = pre1 * pp1[ii];
              const float r0 = __builtin_amdgcn_rcpf(P0), r1 = __builtin_amdgcn_rcpf(P1);
              const float kh0 = kk0[ii] * r0, kh1 = kk1[ii] * r1;
              *(LAS unsigned*)(lds + QH_OFF + i * QST + 4 * kp) = pg8::cvt_pk_bf16(qv0[ii] * P0, qv1[ii] * P1);
              *(LAS unsigned*)(lds + KH_OFF + i * QST + 4 * kp) = pg8::cvt_pk_bf16(kh0, kh1);
              *(LAS unsigned*)(lds + KT_OFF + i * TST + 4 * kp) = pg8::cvt_pk_bf16(kh0 * all0, kh1 * all1);
          }
          DT[0] *= all0; DT[1] *= all1;
          if (sg == 0) *(LAS f32x2*)(lds + DEC_OFF + 2 * kp * 4) = (f32x2){all0, all1}; }
        LBAR();
        if (n + 2 < C.nend) load_raw(Rld, proj, b, hd, dir, n + 2, tid);
        bf16x8 qa[8], sf[8], kf0[8];
#pragma unroll
        for (int ks = 0; ks < 8; ++ks) qa[ks] = *(const LAS bf16x8*)(lds + QH_OFF + (32 * ct + ql) * QST + (16 * ks + 8 * h) * 2);
#pragma unroll
        for (int ks = 0; ks < 8; ++ks) sf[ks] = *(const LAS bf16x8*)(lds + ST_OFF + (32 * vt + ql) * QST + (16 * ks + 8 * h) * 2);
#pragma unroll
        for (int ks = 0; ks < 8; ++ks) kf0[ks] = *(const LAS bf16x8*)(lds + KH_OFF + ql * QST + (16 * ks + 8 * h) * 2);
        asm volatile("" ::: "memory");
        f32x16 OT;
#pragma unroll
        for (int r = 0; r < 16; ++r) OT[r] = 0.f;
#pragma unroll
        for (int ks = 0; ks < 8; ++ks) OT = __builtin_amdgcn_mfma_f32_32x32x16_bf16(sf[ks], qa[ks], OT, 0, 0, 0);
        {
            const LAS unsigned char* va = lds + VV_OFF + (4 * h + q4) * TST + (32 * vt + 16 * dblk + 4 * p4) * 2;
            const s16x4 v0lo = vtr(va), v0hi = vtr(va + 8 * TST), v1lo = vtr(va + 16 * TST), v1hi = vtr(va + 24 * TST);
            asm volatile("" ::: "memory");
            f32x16 X;
#pragma unroll
            for (int r = 0; r < 16; ++r) X[r] = 0.f;
#pragma unroll
            for (int ks = 0; ks < 8; ++ks) X = __builtin_amdgcn_mfma_f32_32x32x16_bf16(kf0[ks], qa[ks], X, 0, 0, 0);
            float xv[16];
#pragma unroll
            for (int r = 0; r < 16; ++r) { const int sl = (r & 3) + 8 * (r >> 2) + 4 * h; xv[r] = (ct > 0 || sl <= ql) ? X[r] : 0.f; }
            OT = __builtin_amdgcn_mfma_f32_32x32x16_bf16(__builtin_shufflevector(v0lo, v0hi, 0, 1, 2, 3, 4, 5, 6, 7), pack8(xv), OT, 0, 0, 0);
            OT = __builtin_amdgcn_mfma_f32_32x32x16_bf16(__builtin_shufflevector(v1lo, v1hi, 0, 1, 2, 3, 4, 5, 6, 7), pack8(xv + 8), OT, 0, 0, 0);
        }
        if (ct > 0) {
            bf16x8 kf1[8];
#pragma unroll
            for (int ks = 0; ks < 8; ++ks) kf1[ks] = *(const LAS bf16x8*)(lds + KH_OFF + (32 + ql) * QST + (16 * ks + 8 * h) * 2);
            const LAS unsigned char* va = lds + VV_OFF + (32 + 4 * h + q4) * TST + (32 * vt + 16 * dblk + 4 * p4) * 2;
            const s16x4 v0lo = vtr(va), v0hi = vtr(va + 8 * TST), v1lo = vtr(va + 16 * TST), v1hi = vtr(va + 24 * TST);
            asm volatile("" ::: "memory");
            f32x16 X;
#pragma unroll
            for (int r = 0; r < 16; ++r) X[r] = 0.f;
#pragma unroll
            for (int ks = 0; ks < 8; ++ks) X = __builtin_amdgcn_mfma_f32_32x32x16_bf16(kf1[ks], qa[ks], X, 0, 0, 0);
            float xv[16];
#pragma unroll
            for (int r = 0; r < 16; ++r) { const int sl = (r & 3) + 8 * (r >> 2) + 4 * h; xv[r] = (sl <= ql) ? X[r] : 0.f; }
            OT = __builtin_amdgcn_mfma_f32_32x32x16_bf16(__builtin_shufflevector(v0lo, v0hi, 0, 1, 2, 3, 4, 5, 6, 7), pack8(xv), OT, 0, 0, 0);
            OT = __builtin_amdgcn_mfma_f32_32x32x16_bf16(__builtin_shufflevector(v1lo, v1hi, 0, 1, 2, 3, 4, 5, 6, 7), pack8(xv + 8), OT, 0, 0, 0);
        }
        {
            bf16x8 vbf[4], kaf[2][4]; f32x4 d4[2][4];
#pragma unroll
            for (int cs = 0; cs < 4; ++cs) {
                const LAS unsigned char* vb_ = lds + VV_OFF + (16 * cs + 8 * h + q4) * TST + (32 * vt + 16 * dblk + 4 * p4) * 2;
                const s16x4 vlo = vtr(vb_), vhi = vtr(vb_ + 4 * TST);
                vbf[cs] = __builtin_shufflevector(vlo, vhi, 0, 1, 2, 3, 4, 5, 6, 7);
#pragma unroll
                for (int j = 0; j < 2; ++j) {
                    const LAS unsigned char* ka = lds + KT_OFF + (16 * cs + 8 * h + q4) * TST + (32 * (2 * ct + j) + 16 * dblk + 4 * p4) * 2;
                    const s16x4 klo = vtr(ka), khi = vtr(ka + 4 * TST);
                    kaf[j][cs] = __builtin_shufflevector(klo, khi, 0, 1, 2, 3, 4, 5, 6, 7);
                }
            }
#pragma unroll
            for (int j = 0; j < 2; ++j)
#pragma unroll
                for (int rg = 0; rg < 4; ++rg) d4[j][rg] = *(const LAS f32x4*)(lds + DEC_OFF + (32 * (2 * ct + j) + 8 * rg + 4 * h) * 4);
            asm volatile("" ::: "memory");
#pragma unroll
            for (int j = 0; j < 2; ++j)
#pragma unroll
                for (int rg = 0; rg < 4; ++rg) { S[j][4 * rg] *= d4[j][rg].x; S[j][4 * rg + 1] *= d4[j][rg].y; S[j][4 * rg + 2] *= d4[j][rg].z; S[j][4 * rg + 3] *= d4[j][rg].w; }
#pragma unroll
            for (int cs = 0; cs < 4; ++cs)
#pragma unroll
                for (int j = 0; j < 2; ++j) S[j] = __builtin_amdgcn_mfma_f32_32x32x16_bf16(kaf[j][cs], vbf[cs], S[j], 0, 0, 0);
        }
        { const int tau = 64 * n + 32 * ct + ql, t = dir ? (SEQ - 1 - tau) : tau;
          bf16* orow = Og + (size_t)(b * SEQ + t) * HW + hd * 128 + 32 * vt;
#pragma unroll
          for (int rg = 0; rg < 4; ++rg) { v2u o; o.x = pg8::cvt_pk_bf16(OT[4 * rg], OT[4 * rg + 1]); o.y = pg8::cvt_pk_bf16(OT[4 * rg + 2], OT[4 * rg + 3]); *(GAS v2u*)(orow + 8 * rg + 4 * h) = o; } }
        LBAR();
#pragma unroll
        for (int j = 0; j < 2; ++j) {
            const int kt = 2 * ct + j;
#pragma unroll
            for (int rg = 0; rg < 4; ++rg) { v2u o; o.x = pg8::cvt_pk_bf16(S[j][4 * rg], S[j][4 * rg + 1]); o.y = pg8::cvt_pk_bf16(S[j][4 * rg + 2], S[j][4 * rg + 3]);
                *(LAS v2u*)(lds + ST_OFF + (32 * vt + ql) * QST + (32 * kt + 8 * rg + 4 * h) * 2) = o; }
        }
        if (n + 1 < C.nend) store_raw(Rst, lds, tid);
        LBAR();
}
constexpr int NSEG = 4, SEGC = (SEQ / 64) / NSEG;
__device__ __forceinline__ void scan_unit(Frame& F, int unit) {
    const int seg = unit & (NSEG - 1), bhd = unit >> 2;
    const int b = bhd >> 5, hd = (bhd >> 1) & 15, dir = bhd & 1;
    const int tid = F.tid, lane = F.lane, w = F.wave;
    LAS unsigned char* lds = F.lds + RING_OFF;
    const bf16* proj = (const bf16*)(F.ws + WS_PROJ);
    bf16* Og = (bf16*)(F.ws + (dir ? WS_OB : WS_OF));
    const float* lb = (const float*)(F.ws + WS_LB) + (dir ? HW : 0) + hd * 128;
    const int ct = w >> 2, vt = w & 3, ql = lane & 31, h = lane >> 5;
    const int q4 = (lane & 15) >> 2, p4 = lane & 3, dblk = (lane >> 4) & 1;
    const int kp = lane, sg = w;
    const float oml0 = 1.f - lb[2 * kp], oml1 = 1.f - lb[2 * kp + 1];
    for (int e = tid; e < 128 * QST / 16; e += 512) *(LAS v4u*)(lds + ST_OFF + 16 * e) = (v4u){0u, 0u, 0u, 0u};
    f32x16 S[2];
#pragma unroll
    for (int j = 0; j < 2; ++j)
#pragma unroll
        for (int r = 0; r < 16; ++r) S[j][r] = 0.f;
    float DT[2] = {1.f, 1.f};
    const int n0 = seg * SEGC, n1 = n0 + SEGC;
    Raw RA, RB;
    load_raw(RA, proj, b, hd, dir, n0, tid);
    load_raw(RB, proj, b, hd, dir, n0 + 1, tid);
    store_raw(RA, lds, tid);
    __syncthreads();
    Ctx C; C.lds = lds; C.proj = proj; C.Og = Og; C.b = b; C.hd = hd; C.dir = dir; C.tid = tid; C.ct = ct; C.vt = vt; C.ql = ql; C.h = h; C.q4 = q4; C.p4 = p4; C.dblk = dblk; C.kp = kp; C.sg = sg; C.nend = n1; C.oml0 = oml0; C.oml1 = oml1;
    for (int n = n0; n < n1; n += 2) {
        scan_step(C, S, DT, RB, RA, n);
        scan_step(C, S, DT, RA, RB, n + 1);
    }
    { GAS f32x4* send = (GAS f32x4*)(F.ws + WS_SEND) + (size_t)unit * 4096;
#pragma unroll
      for (int j = 0; j < 2; ++j)
#pragma unroll
          for (int rg = 0; rg < 4; ++rg) send[((w * 2 + j) * 4 + rg) * 64 + lane] = (f32x4){S[j][4 * rg], S[j][4 * rg + 1], S[j][4 * rg + 2], S[j][4 * rg + 3]};
      if (w == 0) *(GAS f32x2*)((float*)(F.ws + WS_DTOT) + unit * 128 + 2 * kp) = (f32x2){DT[0], DT[1]}; }
}
__device__ __forceinline__ void fixup_unit(Frame& F, int unit) {
    const int seg = unit & (NSEG - 1), bhd = unit >> 2;
    const int b = bhd >> 5, hd = (bhd >> 1) & 15, dir = bhd & 1;
    const int tid = F.tid, lane = F.lane, w = F.wave;
    LAS unsigned char* lds = F.lds + RING_OFF;
    const bf16* proj = (const bf16*)(F.ws + WS_PROJ);
    bf16* Og = (bf16*)(F.ws + (dir ? WS_OB : WS_OF));
    const float* lb = (const float*)(F.ws + WS_LB) + (dir ? HW : 0) + hd * 128;
    const int ct = w >> 2, vt = w & 3, ql = lane & 31, h = lane >> 5;
    const int kp = lane, sg = w;
    const float oml0 = 1.f - lb[2 * kp], oml1 = 1.f - lb[2 * kp + 1];
    f32x16 S[2];
    { const GAS f32x4* send = (const GAS f32x4*)(F.ws + WS_SEND) + (size_t)(bhd * NSEG) * 4096;
      const float* dtot = (const float*)(F.ws + WS_DTOT) + (size_t)(bhd * NSEG) * 128;
#pragma unroll
      for (int j = 0; j < 2; ++j)
#pragma unroll
          for (int rg = 0; rg < 4; ++rg) { const f32x4 e = send[((w * 2 + j) * 4 + rg) * 64 + lane]; S[j][4 * rg] = e.x; S[j][4 * rg + 1] = e.y; S[j][4 * rg + 2] = e.z; S[j][4 * rg + 3] = e.w; }
      for (int g = 1; g < seg; ++g) {
#pragma unroll
          for (int j = 0; j < 2; ++j)
#pragma unroll
              for (int rg = 0; rg < 4; ++rg) { const f32x4 e = send[(size_t)g * 4096 + ((w * 2 + j) * 4 + rg) * 64 + lane]; const f32x4 d = *(const GAS f32x4*)(dtot + g * 128 + 32 * (2 * ct + j) + 8 * rg + 4 * h);
                  S[j][4 * rg] = d.x * S[j][4 * rg] + e.x; S[j][4 * rg + 1] = d.y * S[j][4 * rg + 1] + e.y; S[j][4 * rg + 2] = d.z * S[j][4 * rg + 2] + e.z; S[j][4 * rg + 3] = d.w * S[j][4 * rg + 3] + e.w; }
      } }
    float dc0 = 1.f, dc1 = 1.f;
    const int n0 = seg * SEGC, n1 = n0 + SEGC;
    for (int n = n0; n < n1; ++n) {
        __syncthreads();
#pragma unroll
        for (int j = 0; j < 2; ++j) {
            const int kt = 2 * ct + j;
#pragma unroll
            for (int rg = 0; rg < 4; ++rg) { v2u o; o.x = pg8::cvt_pk_bf16(S[j][4 * rg], S[j][4 * rg + 1]); o.y = pg8::cvt_pk_bf16(S[j][4 * rg + 2], S[j][4 * rg + 3]);
                *(LAS v2u*)(lds + ST_OFF + (32 * vt + ql) * QST + (32 * kt + 8 * rg + 4 * h) * 2) = o; }
        }
        { Raw R; load_raw(R, proj, b, hd, dir, n, tid); store_raw(R, lds, tid); }
        __syncthreads();
        float qv0[8], qv1[8], pp0[8], pp1[8];
        { float run0 = 1.f, run1 = 1.f;
#pragma unroll
          for (int ii = 0; ii < 8; ++ii) {
              const int i = 8 * sg + ii;
              const unsigned qr = *(const LAS unsigned*)(lds + QH_OFF + i * QST + 4 * kp), sr = *(const LAS unsigned*)(lds + KH_OFF + i * QST + 4 * kp);
              qv0[ii] = blo(qr); qv1[ii] = bhi(qr);
              run0 *= (1.f - oml0 * blo(sr)); run1 *= (1.f - oml1 * bhi(sr));
              pp0[ii] = run0; pp1[ii] = run1;
          }
          *(LAS f32x2*)(lds + TOT_OFF + (sg * 128 + 2 * kp) * 4) = (f32x2){run0, run1}; }
        __syncthreads();
        { float pre0 = 1.f, pre1 = 1.f, all0 = 1.f, all1 = 1.f;
#pragma unroll
          for (int s_ = 0; s_ < 8; ++s_) { const f32x2 T = *(const LAS f32x2*)(lds + TOT_OFF + (s_ * 128 + 2 * kp) * 4); all0 *= T.x; all1 *= T.y; if (s_ < sg) { pre0 *= T.x; pre1 *= T.y; } }
#pragma unroll
          for (int ii = 0; ii < 8; ++ii) { const int i = 8 * sg + ii;
              *(LAS unsigned*)(lds + QH_OFF + i * QST + 4 * kp) = pg8::cvt_pk_bf16(qv0[ii] * (pre0 * pp0[ii]), qv1[ii] * (pre1 * pp1[ii])); }
          if (sg == 0) { *(LAS f32x2*)(lds + DEC_OFF + 2 * kp * 4) = (f32x2){all0, all1};
              dc0 *= all0; dc1 *= all1;
              const bool any = __any((dc0 != 0.f) || (dc1 != 0.f)) != 0;
              if (lane == 0) *(LAS unsigned*)(lds + FLAG_OFF) = any ? 1u : 0u; } }
        __syncthreads();
        { bf16x8 qa[8], sf[8];
#pragma unroll
          for (int ks = 0; ks < 8; ++ks) qa[ks] = *(const LAS bf16x8*)(lds + QH_OFF + (32 * ct + ql) * QST + (16 * ks + 8 * h) * 2);
#pragma unroll
          for (int ks = 0; ks < 8; ++ks) sf[ks] = *(const LAS bf16x8*)(lds + ST_OFF + (32 * vt + ql) * QST + (16 * ks + 8 * h) * 2);
          f32x16 OT;
#pragma unroll
          for (int r = 0; r < 16; ++r) OT[r] = 0.f;
#pragma unroll
          for (int ks = 0; ks < 8; ++ks) OT = __builtin_amdgcn_mfma_f32_32x32x16_bf16(sf[ks], qa[ks], OT, 0, 0, 0);
          const int tau = 64 * n + 32 * ct + ql, t = dir ? (SEQ - 1 - tau) : tau;
          bf16* orow = Og + (size_t)(b * SEQ + t) * HW + hd * 128 + 32 * vt;
#pragma unroll
          for (int rg = 0; rg < 4; ++rg) { GAS v2u* p = (GAS v2u*)(orow + 8 * rg + 4 * h); const v2u old = *p;
              v2u o; o.x = pg8::cvt_pk_bf16(blo(old.x) + OT[4 * rg], bhi(old.x) + OT[4 * rg + 1]); o.y = pg8::cvt_pk_bf16(blo(old.y) + OT[4 * rg + 2], bhi(old.y) + OT[4 * rg + 3]); *p = o; } }
#pragma unroll
        for (int j = 0; j < 2; ++j)
#pragma unroll
            for (int rg = 0; rg < 4; ++rg) { const f32x4 d4 = *(const LAS f32x4*)(lds + DEC_OFF + (32 * (2 * ct + j) + 8 * rg + 4 * h) * 4);
                S[j][4 * rg] *= d4.x; S[j][4 * rg + 1] *= d4.y; S[j][4 * rg + 2] *= d4.z; S[j][4 * rg + 3] *= d4.w; }
        const unsigned more = *(const LAS unsigned*)(lds + FLAG_OFF);
        if (__builtin_amdgcn_readfirstlane(more) == 0u) break;
    }
    __syncthreads();
}
}

__device__ __forceinline__ void ohnorm_phase(Frame& F) {
    const int gw = F.vcu * NWAVES + F.wave, NGW = F.G * NWAVES, lane = F.lane;
    const bf16* of = (const bf16*)(F.ws + WS_OF); const bf16* ob = (const bf16*)(F.ws + WS_OB);
    const bf16* proj = (const bf16*)(F.ws + WS_PROJ);
    const float* hn = KIN(7) + (lane & 3) * 32;
    for (int m = gw; m < M; m += NGW) {
        const GAS v4u* a = (const GAS v4u*)(of + (size_t)m * HW + lane * 32);
        const GAS v4u* b = (const GAS v4u*)(ob + (size_t)m * HW + lane * 32);
        const GAS v4u* g = (const GAS v4u*)(proj + (WS_P2 - WS_PROJ) / 2 + (size_t)m * NP2 + C2_HG + lane * 32);
        bf16* xnb = (bf16*)(F.ws + WS_XN);
        float v[32]; float ss = 0.f;
#pragma unroll
        for (int q = 0; q < 4; ++q) { const v4u x = a[q], y = b[q];
            v[q * 8 + 0] = blo(x.x) + blo(y.x); v[q * 8 + 1] = bhi(x.x) + bhi(y.x); v[q * 8 + 2] = blo(x.y) + blo(y.y); v[q * 8 + 3] = bhi(x.y) + bhi(y.y);
            v[q * 8 + 4] = blo(x.z) + blo(y.z); v[q * 8 + 5] = bhi(x.z) + bhi(y.z); v[q * 8 + 6] = blo(x.w) + blo(y.w); v[q * 8 + 7] = bhi(x.w) + bhi(y.w); }
#pragma unroll
        for (int j = 0; j < 32; ++j) ss += v[j] * v[j];
        ss += __shfl_xor(ss, 1); ss += __shfl_xor(ss, 2);
        const float rstd = 1.f / sqrtf(ss * (1.f / 128.f) + EPS);
#pragma unroll
        for (int q = 0; q < 4; ++q) { const v4u z = g[q];
            float gg[8] = {blo(z.x), bhi(z.x), blo(z.y), bhi(z.y), blo(z.z), bhi(z.z), blo(z.w), bhi(z.w)};
            float r[8];
#pragma unroll
            for (int j = 0; j < 8; ++j) r[j] = v[q * 8 + j] * rstd * hn[q * 8 + j] * gg[j];
            v4u w; w.x = pk2(r[0], r[1]); w.y = pk2(r[2], r[3]); w.z = pk2(r[4], r[5]); w.w = pk2(r[6], r[7]); *(GAS v4u*)(xnb + tiled_off(m, lane * 32 + 8 * q, D)) = w; }
    }
}

template <int KIND>
__device__ __forceinline__ void resid_phase(Frame& F, const bf16* Y, const float* xin, const bf16* bin, bf16* XB, const float* wpost, const float* wpre) {
    const int gw = F.vcu * NWAVES + F.wave, NGW = F.G * NWAVES, lane = F.lane;
    const float* SS = (const float*)(F.ws + WS_SS);
#pragma nounroll
    for (int m = gw; m < M; m += NGW) {
        const GAS v2u* y2 = (const GAS v2u*)(Y + (size_t)m * D) + lane;
        const GAS f32x4* x4 = (const GAS f32x4*)(xin + (size_t)m * D) + lane;
        const GAS v2u* b2 = (const GAS v2u*)(bin + (size_t)m * D) + lane;
        const GAS f32x4* w4 = (const GAS f32x4*)wpost + lane;
        GAS f32x4* o4 = (GAS f32x4*)(F.out + (size_t)m * D) + lane;
        GAS v2u* xb = (GAS v2u*)(XB + (size_t)m * D) + lane;
        bf16* xnb = (bf16*)(F.ws + WS_XN);
        const float rstd = 1.f / sqrtf(wave_sum(SS[(size_t)m * 64 + lane]) * (1.f / D) + EPS);
        f32x4 v[16]; float s2 = 0.f;
#pragma unroll
        for (int hh = 0; hh < 2; ++hh) {
            v2u yv[8]; f32x4 wv[8];
#pragma unroll
            for (int jj = 0; jj < 8; ++jj) { const int j = 8 * hh + jj; yv[jj] = y2[64 * j]; wv[jj] = w4[64 * j];
                if (KIND == 0) v[j] = x4[64 * j];
                else { const v2u bb = (KIND == 2) ? *(const GAS v2u*)(bin + tiled_off(m, 4 * lane + 256 * j, D)) : b2[64 * j]; v[j] = (f32x4){blo(bb.x), bhi(bb.x), blo(bb.y), bhi(bb.y)}; } }
            asm volatile("" ::: "memory");
#pragma unroll
            for (int jj = 0; jj < 8; ++jj) { const int j = 8 * hh + jj; const v2u y = yv[jj]; const f32x4 w = wv[jj]; const f32x4 x = v[j];
                f32x4 r; r.x = x.x + blo(y.x) * rstd * w.x; r.y = x.y + bhi(y.x) * rstd * w.y; r.z = x.z + blo(y.y) * rstd * w.z; r.w = x.w + bhi(y.y) * rstd * w.w;
                if (KIND == 0) { v[j] = r; s2 += (r.x * r.x + r.y * r.y) + (r.z * r.z + r.w * r.w); v2u o; o.x = pk2(r.x, r.y); o.y = pk2(r.z, r.w); xb[64 * j] = o; }
                if (KIND == 1) { v2u o; o.x = pk2(r.x, r.y); o.y = pk2(r.z, r.w); *(GAS v2u*)(xnb + tiled_off(m, 4 * lane + 256 * j, D)) = o; }
                if (KIND == 2) o4[64 * j] = r; }
        }
        if (KIND == 0) {
            const float r2 = 1.f / sqrtf(wave_sum(s2) * (1.f / D) + EPS);
            const GAS f32x4* p4 = (const GAS f32x4*)wpre + lane;
#pragma unroll
            for (int j = 0; j < 16; ++j) { const f32x4 g = p4[64 * j];
                v2u o; o.x = pk2(v[j].x * r2 * g.x, v[j].y * r2 * g.y); o.y = pk2(v[j].z * r2 * g.z, v[j].w * r2 * g.w); *(GAS v2u*)(xnb + tiled_off(m, 4 * lane + 256 * j, D)) = o; }
        }
    }
}

struct Args { const float* in[19]; float* out; unsigned char* ws; int ph_lo, ph_hi, li, pad; };
__global__ void __launch_bounds__(NWAVES * 64, 2) skel_fwd(Args args) {
    extern __shared__ __attribute__((aligned(16))) unsigned char lds[];
    Frame F;
    F.lds = (LAS unsigned char*)lds;
    F.MISC = (volatile LAS unsigned*)(F.lds + MISC_OFF);
    F.tid = threadIdx.x; F.lane = F.tid & 63; F.wave = __builtin_amdgcn_readfirstlane(F.tid >> 6);
    F.G = gridDim.x; { const int bx = blockIdx.x; F.vcu = (F.G % 8 == 0) ? (bx % 8) * (F.G / 8) + bx / 8 : bx; }
    unsigned char* ws = args.ws; F.ws = ws;
    F.ctl = (gu32*)(ws + WS_CTL);
    F.out = args.out;
    for (int u = F.tid; u < (LDS_BYTES - LDSCTL_OFF) / 4; u += NWAVES * 64) ((LAS unsigned*)(F.lds + LDSCTL_OFF))[u] = 0u;
    __syncthreads();
    XcdBarrier bar; bar.bar = (unsigned*)(F.ctl + CW_BAR); bar.x = 0; bar.st = nullptr;
    if (ONE_LAUNCH) bar = xcd_barrier_post((unsigned*)(F.ctl + CW_BAR), F.MISC + 8);
#define GRID_BAR() do { if (ONE_LAUNCH) xcd_barrier(bar); } while (0)
#define SELF_ACQ() do { asm volatile("s_waitcnt vmcnt(0)" ::: "memory"); __syncthreads(); __builtin_amdgcn_fence(__ATOMIC_ACQUIRE, "agent"); asm volatile("s_waitcnt vmcnt(0)" ::: "memory"); __syncthreads(); } while (0)
    const int lo = args.ph_lo, hi = args.ph_hi;
#define IN(k) (lo <= (k) && (k) < hi)
#define BOTH(k) (IN(k) && IN((k) + 1))
    bf16* XN = (bf16*)(ws + WS_XN); bf16* P2 = (bf16*)(ws + WS_P2); float* SS = (float*)(ws + WS_SS);
    const int c = (int)blockIdx.x;

    if (IN(0)) { p0_prologue(F); if (BOTH(0)) GRID_BAR(); }
    if (IN(1)) {
        pg8::Gemm g{XN, (const bf16*)(ws + WS_WIN), M, NIN, D, D / 64, D}; pg8::StaticOrder S; S.init(M, NIN, F.G, c);
        pg8::Epi<6> E{P2, NP2, nullptr, 0, nullptr, 0, nullptr, (bf16*)(ws + WS_PROJ)};
        pg8::gemm_phase<pg8::Epi<6>, pg8::StaticOrder, PG8_ALIGN, PG8_SP2>(F.lds + RING_OFF, g, S, E);
        if (BOTH(1)) GRID_BAR();
    }
    if (IN(2)) {
        for (int u = c; u < 64 * scn::NSEG; u += F.G) scn::scan_unit(F, u);
        for (int u = c; u < 1024; u += F.G) att::attn_unit(F, u);
        if (BOTH(2)) GRID_BAR();
    }
    if (IN(3)) {
        for (int u = c; u < 64 * scn::NSEG; u += F.G) if (u & (scn::NSEG - 1)) scn::fixup_unit(F, u);
        if (BOTH(3)) GRID_BAR();
    }
    if (IN(4)) { ohnorm_phase(F); if (BOTH(4)) GRID_BAR(); }
    if (IN(5)) {
        pg8::Gemm g{XN, (const bf16*)(ws + WS_WHP), M, D, HW, D / 64, HW}; pg8::StaticOrder S; S.init(M, D, F.G, c);
        pg8::Epi<1> E{P2 + C2_GA, NP2, P2 + C2_GA, NP2, nullptr, 0, nullptr};
        pg8::gemm_phase<pg8::Epi<1>, pg8::StaticOrder, PG8_ALIGN, PG8_SP2>(F.lds + RING_OFF, g, S, E);
        if (BOTH(5)) SELF_ACQ();
    }
    if (IN(6)) {
        pg8::Gemm g{XN + (size_t)(HW / 64) * (256 * 64), (const bf16*)(ws + WS_WAP), M, D, HW, D / 64, HW}; pg8::StaticOrder S; S.init(M, D, F.G, c);
        pg8::Epi<2> E{(bf16*)(ws + WS_Y), D, P2 + C2_GA, NP2, P2 + C2_GB, NP2, nullptr, nullptr, D / 64};
        pg8::gemm_phase<pg8::Epi<2>, pg8::StaticOrder, PG8_ALIGN, PG8_SP2>(F.lds + RING_OFF, g, S, E);
        if (BOTH(6)) GRID_BAR();
    }
    if (IN(7)) {
        pg8::Gemm g{(const bf16*)(ws + WS_Y), (const bf16*)(ws + WS_WOUT), M, D, D, D / 64, D}; pg8::StaticOrder S; S.init(M, D, F.G, c);
        pg8::Epi<3> E{(bf16*)(ws + WS_MIX), D, nullptr, 0, nullptr, 0, SS};
        pg8::gemm_phase<pg8::Epi<3>, pg8::StaticOrder, PG8_ALIGN, PG8_SP2>(F.lds + RING_OFF, g, S, E);
        if (BOTH(7)) GRID_BAR();
    }
    if (IN(8)) { resid_phase<0>(F, (const bf16*)(ws + WS_MIX), KIN(0), XN, (bf16*)F.out, KIN(3), KIN(12)); if (BOTH(8)) GRID_BAR(); }
    if (IN(9)) {
        pg8::Gemm g{XN, (const bf16*)(ws + WS_WUP), M, DFF, D, D / 64, D}; pg8::StaticOrder S; S.init(M, DFF, F.G, c);
        pg8::Epi<4> E{(bf16*)(ws + WS_U), DFF, nullptr, 0, nullptr, 0, nullptr, nullptr, DFF / 64};
        pg8::gemm_phase<pg8::Epi<4>, pg8::StaticOrder, PG8_ALIGN, PG8_SP2>(F.lds + RING_OFF, g, S, E);
        if (BOTH(9)) GRID_BAR();
    }
    if (IN(10)) {
        pg8::Gemm g{(const bf16*)(ws + WS_U), (const bf16*)(ws + WS_WDN), M, D, DFF, DFF / 64, DFF}; pg8::StaticOrder S; S.init(M, D, F.G, c);
        pg8::Epi<3> E{(bf16*)(ws + WS_MIX), D, nullptr, 0, nullptr, 0, SS};
        pg8::gemm_phase<pg8::Epi<3>, pg8::StaticOrder, PG8_ALIGN, PG8_SP2>(F.lds + RING_OFF, g, S, E);
        if (BOTH(10)) GRID_BAR();
    }
    if (IN(11)) { resid_phase<1>(F, (const bf16*)(ws + WS_MIX), KIN(0), (const bf16*)F.out, (bf16*)F.out, KIN(13), nullptr); if (BOTH(11)) GRID_BAR(); }
    if (IN(12)) {
        pg8::Gemm g{(const bf16*)(ws + WS_PBF), (const bf16*)(ws + WS_WPLE), M, D, PLE, PLE / 64, PLE}; pg8::StaticOrder S; S.init(M, D, F.G, c);
        pg8::Epi<0> E{(bf16*)(ws + WS_E), D, nullptr, 0, nullptr, 0, nullptr};
        pg8::gemm_phase<pg8::Epi<0>, pg8::StaticOrder, PG8_ALIGN, PG8_SP2>(F.lds + RING_OFF, g, S, E);
        if (BOTH(12)) SELF_ACQ();
    }
    if (IN(13)) {
        pg8::Gemm g{XN, (const bf16*)(ws + WS_WPG), M, D, D, D / 64, D}; pg8::StaticOrder S; S.init(M, D, F.G, c);
        pg8::Epi<5> E{(bf16*)(ws + WS_V), D, (const bf16*)(ws + WS_E), D, nullptr, 0, SS};
        pg8::gemm_phase<pg8::Epi<5>, pg8::StaticOrder, PG8_ALIGN, PG8_SP2>(F.lds + RING_OFF, g, S, E);
        if (BOTH(13)) GRID_BAR();
    }
    if (IN(14)) { resid_phase<2>(F, (const bf16*)(ws + WS_V), KIN(0), XN, (bf16*)F.out, KIN(18), nullptr); }
#undef IN
#undef BOTH
#undef GRID_BAR
}

extern "C" void kernel_launch(void* const* d_in, const int* in_sizes, int n_in, void* d_out, int out_size, void* d_ws, size_t ws_size, hipStream_t stream) {
    static int grid = 0;
    if (grid == 0) {
        if (n_in != 19 || in_sizes[0] != M * D || out_size != M * D || ws_size < WS_END) { fprintf(stderr, "kernel_launch: unexpected shapes: n_in %d in0 %d out %d ws %zu (need %zu)\n", n_in, n_in > 0 ? in_sizes[0] : -1, out_size, ws_size, (size_t)WS_END); grid = -1; return; }
        int dev = 0, cus = 0, per_cu = 0;
        if (hipGetDevice(&dev) != hipSuccess || hipDeviceGetAttribute(&cus, hipDeviceAttributeMultiprocessorCount, dev) != hipSuccess) { fprintf(stderr, "kernel_launch: device query failed\n"); grid = -1; return; }
        if (hipFuncSetAttribute((const void*)skel_fwd, hipFuncAttributeMaxDynamicSharedMemorySize, LDS_BYTES) != hipSuccess) { fprintf(stderr, "kernel_launch: hipFuncSetAttribute failed\n"); grid = -1; return; }
        if (hipOccupancyMaxActiveBlocksPerMultiprocessor(&per_cu, (const void*)skel_fwd, NWAVES * 64, LDS_BYTES) != hipSuccess || per_cu < 1)
            fprintf(stderr, "kernel_launch: note: occupancy query reports %d workgroups per CU\n", per_cu);
        (void)hipGetLastError();
        grid = cus;
    }
    if (grid < 0) return;
    if (hipMemsetAsync((char*)d_ws + WS_CTL, 0, CTL_ZERO_BYTES, stream) != hipSuccess) { fprintf(stderr, "kernel_launch: memset failed\n"); return; }
    Args a{};
    for (int i = 0; i < 19; ++i) a.in[i] = (const float*)d_in[i];
    a.out = (float*)d_out; a.ws = (unsigned char*)d_ws;
    const int nl = ONE_LAUNCH ? 1 : NPH;
    for (int li = 0; li < nl; ++li) {
        a.ph_lo = ONE_LAUNCH ? 0 : li; a.ph_hi = ONE_LAUNCH ? NPH : li + 1; a.li = li; a.pad = 0;
        hipLaunchKernelGGL(skel_fwd, dim3(grid), dim3(NWAVES * 64), LDS_BYTES, stream, a);
        const hipError_t le = hipPeekAtLastError();
        if (le != hipSuccess) { fprintf(stderr, "kernel_launch: launch %d failed: %s\n", li, hipGetErrorName(le)); break; }
    }
}
```

```cpp
#include <hip/hip_runtime.h>
#include <cstdio>
#include <cstdint>

namespace pg8 {
#define PG8_LAS __attribute__((address_space(3)))
typedef unsigned short bf16_t;
typedef short bf16x8 __attribute__((ext_vector_type(8)));
typedef float f32x4 __attribute__((ext_vector_type(4)));
typedef unsigned u32x4 __attribute__((ext_vector_type(4)));
constexpr int BM = 256, BK = 64, HALF = 128, HTB = HALF * BK * 2, STAGE_BYTES = 8 * HTB, NXCD = 8, WGM = 8;

__host__ __device__ __forceinline__ int lds_byte(int r, int c) { const int st = (r >> 4) * 2 + (c >> 5), rr = r & 15, cc = c & 31, ob = rr * 64 + cc * 2; return st * 1024 + (ob ^ (((ob >> 9) & 1) << 5)); }
__host__ __device__ __forceinline__ void stage_rc(int b, int& R, int& C) { const int st = b / 1024, sb = b % 1024, swz = sb ^ (((sb >> 9) & 1) << 5); R = (st >> 1) * 16 + swz / 64; C = (st & 1) * 32 + (swz % 64) / 2; }
__host__ __device__ __forceinline__ int perm32(int rho) { const int n = rho >> 4, i = rho & 15; return 8 * (i >> 2) + 4 * n + (i & 3); }

struct Unit { int pm, pn; };
struct Gemm { const bf16_t* A; const bf16_t* Bt; int M, N, K, lda, ldb; };

struct StaticOrder {
    int nM, nN, nwg, G, c;
    __host__ __device__ void init(int M, int N, int G_, int c_) { nM = M / BM; nN = N / BM; nwg = nM * nN; G = G_; c = c_; }
    __host__ __device__ bool next(int i, Unit& u) const {
        const long L = (long)i * G + c; if (L >= nwg) return false;
        int wgid = (int)L; { const int q = nwg / NXCD, r = nwg % NXCD, xcd = wgid % NXCD, off = wgid / NXCD; wgid = (xcd < r ? xcd * (q + 1) : r * (q + 1) + (xcd - r) * q) + off; }
        const int nig = WGM * nN, gid = wgid / nig, fm = gid * WGM, gsz = (nM - fm) < WGM ? (nM - fm) : WGM;
        u.pm = fm + ((wgid % nig) % gsz); u.pn = (wgid % nig) / gsz; return true;
    }
    __device__ __forceinline__ void a_ready(const Unit&) const {}
    __device__ __forceinline__ void done(const Unit&) const {}
};

typedef float f32x2_t __attribute__((ext_vector_type(2)));
typedef __bf16 bf16x2_t __attribute__((ext_vector_type(2)));
__device__ __forceinline__ unsigned cvt_pk_bf16(float lo, float hi) { const f32x2_t v = {lo, hi}; return __builtin_bit_cast(unsigned, __builtin_convertvector(v, bf16x2_t)); }
__device__ __forceinline__ float sigm(float x) { return __builtin_amdgcn_rcpf(1.0f + __expf(-x)); }
__device__ __forceinline__ float bflo(unsigned w) { return __uint_as_float(w << 16); }
__device__ __forceinline__ float bfhi(unsigned w) { return __uint_as_float(w & 0xffff0000u); }

template <int MODE> struct Epi {
    static constexpr bool PERM = true, AFTER_DRAIN = false;
    bf16_t* O; int ldc; const bf16_t* G1; int ldg1; const bf16_t* G2; int ldg2; float* SS;
    bf16_t* CB;
    int tkt;
    __device__ __forceinline__ void operator()(const f32x4 (&acc)[2][2][4][2], const Unit& u, int wr, int wc, int fr, int fq) const {
        if constexpr (MODE == 6) {
            const int pn = u.pn;
            const int am = (pn < 8) ? 1 : (pn < 24) ? 2 : (pn >= 32 && pn < 40) ? 3 : 0;
            bf16_t* ob; size_t rs, bs; int rsub;
            const int bb = (u.pm * BM) / 8192;
            if (pn < 32 || (pn >= 40 && pn < 52)) {
                size_t toff; int h0, nh;
                if (pn < 32) { toff = (size_t)(pn >> 3) << 25; h0 = (pn & 7) * 2; nh = 16; }
                else if (pn < 48) { toff = (size_t)128 << 20; h0 = (pn - 40) * 2; nh = 16; }
                else if (pn < 50) { toff = (size_t)160 << 20; h0 = (pn - 48) * 2; nh = 4; }
                else { toff = (size_t)168 << 20; h0 = (pn - 50) * 2; nh = 4; }
                ob = CB + toff + (size_t)(bb * nh + h0) * 8192 * 128 + wc * 32 + 8 * fq; rs = 128; bs = (size_t)8192 * 128; rsub = bb * 8192;
            } else {
                const int c2 = (pn < 40) ? (pn - 32) * 256 : (pn - 52) * 256 + 2048;
                ob = O + c2 + wc * 32 + 8 * fq; rs = (size_t)ldc; bs = HALF; rsub = 0;
            }
            if (am == 0) run<0>(acc, u, wr, wc, fr, fq, 0, ob, rs, bs, rsub); else if (am == 1) run<7>(acc, u, wr, wc, fr, fq, 1, ob, rs, bs, rsub); else if (am == 2) run<8>(acc, u, wr, wc, fr, fq, 2, ob, rs, bs, rsub); else run<9>(acc, u, wr, wc, fr, fq, 3, ob, rs, bs, rsub);
        } else if (tkt > 0) run<MODE>(acc, u, wr, wc, fr, fq, 0, O + (size_t)(u.pm * tkt + u.pn * 4 + (wc >> 1)) * (BM * BK) + 32 * (wc & 1) + 8 * fq, (size_t)BK, (size_t)2 * BM * BK, u.pm * BM);
        else run<MODE>(acc, u, wr, wc, fr, fq, 0, O + u.pn * BM + wc * 32 + 8 * fq, (size_t)ldc, (size_t)HALF, 0);
    }
    template <int MD> __device__ __forceinline__ void run(const f32x4 (&acc)[2][2][4][2], const Unit& u, int wr, int wc, int fr, int fq, int am, bf16_t* ob, size_t rs, size_t bs, int rsub) const {
        const int row0 = u.pm * BM + wr * 64 + fr, col0 = u.pn * BM + wc * 32 + 8 * fq;
#pragma unroll
        for (int ai = 0; ai < 2; ++ai) {
            u32x4 g1v[4][2], g2v[4][2];
            if (MD == 1 || MD == 5) {
#pragma unroll
                for (int m = 0; m < 4; ++m)
#pragma unroll
                    for (int bj = 0; bj < 2; ++bj) g1v[m][bj] = *(const u32x4*)(G1 + (size_t)(row0 + ai * HALF + m * 16) * ldg1 + col0 + bj * HALF);
                asm volatile("" ::: "memory");
            }
#pragma unroll
            for (int m = 0; m < 4; ++m) {
                const int row = row0 + ai * HALF + m * 16; float ssq = 0.f;
                if (MD == 2) {
#pragma unroll
                    for (int bj = 0; bj < 2; ++bj) { g1v[m][bj] = *(const u32x4*)(G1 + (size_t)row * ldg1 + col0 + bj * HALF); g2v[m][bj] = *(const u32x4*)(G2 + (size_t)row * ldg2 + col0 + bj * HALF); }
                }
#pragma unroll
                for (int bj = 0; bj < 2; ++bj) {
                    float v[8];
#pragma unroll
                    for (int j = 0; j < 4; ++j) { v[j] = acc[ai][bj][m][0][j]; v[4 + j] = acc[ai][bj][m][1][j]; }
                    if (MD == 1 || MD == 2 || MD == 5) {
                        const u32x4 a = g1v[m][bj];
                        float g[8] = {bflo(a.x), bfhi(a.x), bflo(a.y), bfhi(a.y), bflo(a.z), bfhi(a.z), bflo(a.w), bfhi(a.w)};
                        if (MD == 1) {
#pragma unroll
                            for (int j = 0; j < 8; ++j) v[j] = sigm(g[j]) * v[j];
                        } else if (MD == 5) {
#pragma unroll
                            for (int j = 0; j < 8; ++j) v[j] = g[j] * sigm(v[j]);
                        } else {
                            const u32x4 b = g2v[m][bj];
                            float h[8] = {bflo(b.x), bfhi(b.x), bflo(b.y), bfhi(b.y), bflo(b.z), bfhi(b.z), bflo(b.w), bfhi(b.w)};
#pragma unroll
                            for (int j = 0; j < 8; ++j) v[j] = g[j] + sigm(h[j]) * v[j];
                        }
                    }
                    if (MD == 7) {
#pragma unroll
                        for (int j = 0; j < 8; ++j) v[j] = v[j] * sigm(v[j]) * 0.08838834764831845f;
                    }
                    if (MD == 8) {
#pragma unroll
                        for (int j = 0; j < 8; ++j) v[j] = sigm(-v[j]);
                    }
                    if (MD == 9) {
#pragma unroll
                        for (int j = 0; j < 8; ++j) v[j] = v[j] * sigm(v[j]);
                    }
                    if (MD == 4) {
#pragma unroll
                        for (int j = 0; j < 8; ++j) { const float r = fmaxf(v[j], 0.f); v[j] = r * r; }
                    }
                    if (MD == 3 || MD == 5) {
#pragma unroll
                        for (int j = 0; j < 8; ++j) ssq += v[j] * v[j];
                    }
                    u32x4 w; w.x = cvt_pk_bf16(v[0], v[1]); w.y = cvt_pk_bf16(v[2], v[3]); w.z = cvt_pk_bf16(v[4], v[5]); w.w = cvt_pk_bf16(v[6], v[7]);
                    *(u32x4*)(ob + (size_t)(row - rsub) * rs + bj * bs) = w;
                }
                if (MD == 3 || MD == 5) {
                    ssq += __shfl_xor(ssq, 16); ssq += __shfl_xor(ssq, 32);
                    if (fq == 0) SS[(size_t)row * 64 + u.pn * 4 + wc] = ssq;
                }
            }
        }
    }
};

template <class Epi, class Sched, bool ALIGN_EPI = false, bool SP2 = false>
__device__ __forceinline__ void gemm_phase(PG8_LAS unsigned char* lds, const Gemm g, const Sched& S, const Epi& E) {
    const int tid = threadIdx.x, wid = __builtin_amdgcn_readfirstlane(tid >> 6), lane = tid & 63, wr = wid >> 2, wc = wid & 3, fr = lane & 15, fq = lane >> 4;
    const int K = g.K, nt = K / BK;
    unsigned voffA[2], voffB[2];
#pragma unroll
    for (int i = 0; i < 2; ++i) { int R, C; stage_rc(tid * 16 + i * 8192, R, C); const int Rb = Epi::PERM ? ((R & ~31) + perm32(R & 31)) : R;
        voffA[i] = (unsigned)(R * BK + C) * 2u; voffB[i] = (unsigned)(Rb * BK + C) * 2u; }
    const size_t kstep = (size_t)BM * BK * 2, kstepB = kstep;
    const size_t hsA = (size_t)HALF * BK * 2, hsB = hsA;
    const size_t tsA = (size_t)g.lda * kstep, tsB = (size_t)nt * kstepB;
    const unsigned ldsw = (unsigned)wid * 1024u;
    const int aoff = lds_byte(wr * 64 + fr, fq * 8), boff = lds_byte(wc * 32 + fr, fq * 8);
#define PG8_SA(b, h) (((b) * 2 + (h)) * HTB)
#define PG8_SB(b, h) ((4 + (b) * 2 + (h)) * HTB)
#define PG8_STAGE(bufoff, gbase, voff) do { _Pragma("unroll") for (int _i = 0; _i < 2; ++_i) \
        __builtin_amdgcn_global_load_lds((const unsigned*)((const char*)(gbase) + (voff)[_i]), (PG8_LAS unsigned*)(lds + (bufoff) + ldsw + _i * 8192), 16, 0, 0); } while (0)
#define PG8_LDA(dst, b, h) do { _Pragma("unroll") for (int m = 0; m < 4; ++m) _Pragma("unroll") for (int k = 0; k < 2; ++k) dst[m][k] = *(const PG8_LAS bf16x8*)(lds + PG8_SA(b, h) + aoff + m * 2048 + k * 1024); } while (0)
#define PG8_LDB(dst, b, h) do { _Pragma("unroll") for (int n = 0; n < 2; ++n) _Pragma("unroll") for (int k = 0; k < 2; ++k) dst[n][k] = *(const PG8_LAS bf16x8*)(lds + PG8_SB(b, h) + boff + n * 2048 + k * 1024); } while (0)
#define PG8_MMA(ai, bj, At, Bt) do { __builtin_amdgcn_s_setprio(1); _Pragma("unroll") for (int m = 0; m < 4; ++m) _Pragma("unroll") for (int n = 0; n < 2; ++n) _Pragma("unroll") for (int k = 0; k < 2; ++k) \
        acc[ai][bj][m][n] = __builtin_amdgcn_mfma_f32_16x16x32_bf16(Bt[n][k], At[m][k], acc[ai][bj][m][n], 0, 0, 0); __builtin_amdgcn_s_setprio(0); } while (0)
#define PG8_WAIT_V(n) asm volatile("s_waitcnt vmcnt(" #n ")" ::: "memory")
#define PG8_WAIT_L(n) asm volatile("s_waitcnt lgkmcnt(" #n ")" ::: "memory")
#define PG8_BAR __builtin_amdgcn_s_barrier()
#define PG8_SCHED __builtin_amdgcn_sched_barrier(0)
    Unit cur, nxt; int ui = 0;
    if (!S.next(0, cur)) return;
    f32x4 acc[2][2][4][2];
#pragma unroll
    for (int a = 0; a < 2; ++a)
#pragma unroll
        for (int b = 0; b < 2; ++b)
#pragma unroll
            for (int m = 0; m < 4; ++m)
#pragma unroll
                for (int n = 0; n < 2; ++n) acc[a][b][m][n] = (f32x4){0.f, 0.f, 0.f, 0.f};
    bf16x8 At[4][2], B0[2][2], B1[2][2];
    const char* cA = (const char*)g.A + (size_t)cur.pm * tsA; const char* cB = (const char*)g.Bt + (size_t)cur.pn * tsB;
    S.a_ready(cur);
    if constexpr (SP2) {
        PG8_STAGE(PG8_SB(0, 0), cB, voffB); PG8_STAGE(PG8_SB(0, 1), cB + hsB, voffB); PG8_STAGE(PG8_SA(0, 0), cA, voffA); PG8_STAGE(PG8_SA(0, 1), cA + hsA, voffA);
        if (wr == 1) PG8_BAR;
        PG8_WAIT_V(2); PG8_BAR;
        PG8_STAGE(PG8_SB(1, 0), cB + kstepB, voffB); PG8_STAGE(PG8_SA(1, 0), cA + kstep, voffA); PG8_STAGE(PG8_SB(1, 1), cB + hsB + kstepB, voffB);
        PG8_WAIT_V(6); PG8_BAR;
    } else {
        PG8_STAGE(PG8_SB(0, 0), cB, voffB); PG8_STAGE(PG8_SA(0, 0), cA, voffA); PG8_STAGE(PG8_SB(0, 1), cB + hsB, voffB); PG8_STAGE(PG8_SA(0, 1), cA + hsA, voffA);
        if (wr == 1) PG8_BAR;
        PG8_WAIT_V(4); PG8_BAR;
        PG8_STAGE(PG8_SB(1, 0), cB + kstepB, voffB); PG8_STAGE(PG8_SA(1, 0), cA + kstep, voffA); PG8_STAGE(PG8_SB(1, 1), cB + hsB + kstepB, voffB);
        PG8_WAIT_V(6); PG8_BAR;
    }
    for (;;) {
        const bool has_next = S.next(ui + 1, nxt);
        const char* nA = has_next ? (const char*)g.A + (size_t)nxt.pm * tsA : cA; const char* nB = has_next ? (const char*)g.Bt + (size_t)nxt.pn * tsB : cB;
#pragma nounroll
        for (int t = 0; t < nt; t += 2) {
            const bool last = (t == nt - 2);
            const char* a1 = cA + (size_t)(t + 1) * kstep;
            const char* a2 = last ? nA : cA + (size_t)(t + 2) * kstep; const char* b2 = last ? nB : cB + (size_t)(t + 2) * kstepB;
            const char* a3 = a2 + kstep; const char* b3 = b2 + kstepB;
            if (last && has_next) S.a_ready(nxt);
            if constexpr (SP2) {
            PG8_LDB(B0, 0, 0); PG8_LDB(B1, 0, 1); PG8_SCHED; PG8_LDA(At, 0, 0); PG8_STAGE(PG8_SA(1, 1), a1 + hsA, voffA);
            PG8_WAIT_V(8); PG8_WAIT_L(0); PG8_BAR; PG8_MMA(0, 0, At, B0); PG8_MMA(0, 1, At, B1); PG8_BAR; PG8_SCHED;
            PG8_LDA(At, 0, 1); PG8_STAGE(PG8_SB(0, 0), b2, voffB); PG8_STAGE(PG8_SB(0, 1), b2 + hsB, voffB); PG8_STAGE(PG8_SA(0, 0), a2, voffA);
            PG8_WAIT_V(8); PG8_WAIT_L(0); PG8_BAR; PG8_MMA(1, 0, At, B0); PG8_MMA(1, 1, At, B1); PG8_BAR; PG8_SCHED;
            PG8_LDB(B0, 1, 0); PG8_LDB(B1, 1, 1); PG8_SCHED; PG8_LDA(At, 1, 0); PG8_STAGE(PG8_SA(0, 1), a2 + hsA, voffA);
            PG8_WAIT_V(8); PG8_WAIT_L(0); PG8_BAR; PG8_MMA(0, 0, At, B0); PG8_MMA(0, 1, At, B1); PG8_BAR; PG8_SCHED;
            PG8_LDA(At, 1, 1); PG8_STAGE(PG8_SB(1, 0), b3, voffB); PG8_STAGE(PG8_SB(1, 1), b3 + hsB, voffB); PG8_STAGE(PG8_SA(1, 0), a3, voffA);
            PG8_WAIT_V(8); PG8_WAIT_L(0); PG8_BAR; PG8_MMA(1, 0, At, B0); PG8_MMA(1, 1, At, B1); PG8_BAR; PG8_SCHED;
            } else {
            PG8_LDB(B0, 0, 0); PG8_SCHED; PG8_LDA(At, 0, 0); PG8_STAGE(PG8_SA(1, 1), a1 + hsA, voffA);
            PG8_WAIT_L(8); PG8_BAR; PG8_WAIT_L(0); PG8_MMA(0, 0, At, B0); PG8_BAR; PG8_SCHED;
            PG8_LDB(B1, 0, 1); PG8_STAGE(PG8_SB(0, 0), b2, voffB);
            PG8_BAR; PG8_WAIT_L(0); PG8_MMA(0, 1, At, B1); PG8_BAR;
            PG8_LDA(At, 0, 1); PG8_STAGE(PG8_SA(0, 0), a2, voffA);
            PG8_BAR; PG8_WAIT_L(0); PG8_MMA(1, 0, At, B0); PG8_BAR; PG8_SCHED;
            PG8_STAGE(PG8_SB(0, 1), b2 + hsB, voffB);
            PG8_WAIT_V(6); PG8_BAR; PG8_MMA(1, 1, At, B1); PG8_BAR;
            PG8_LDB(B0, 1, 0); PG8_SCHED; PG8_LDA(At, 1, 0); PG8_STAGE(PG8_SA(0, 1), a2 + hsA, voffA);
            PG8_WAIT_L(8); PG8_BAR; PG8_WAIT_L(0); PG8_MMA(0, 0, At, B0); PG8_BAR; PG8_SCHED;
            PG8_LDB(B1, 1, 1); PG8_STAGE(PG8_SB(1, 0), b3, voffB);
            PG8_BAR; PG8_WAIT_L(0); PG8_MMA(0, 1, At, B1); PG8_BAR;
            PG8_LDA(At, 1, 1); PG8_STAGE(PG8_SA(1, 0), a3, voffA);
            PG8_BAR; PG8_WAIT_L(0); PG8_MMA(1, 0, At, B0); PG8_BAR; PG8_SCHED;
            PG8_STAGE(PG8_SB(1, 1), b3 + hsB, voffB);
            PG8_WAIT_V(6); PG8_BAR; PG8_MMA(1, 1, At, B1); PG8_BAR;
            }
        }
        if constexpr (ALIGN_EPI) { if (wr == 0) PG8_BAR; }
        if constexpr (!Epi::AFTER_DRAIN) { E(acc, cur, wr, wc, fr, fq); S.done(cur); }
        if (!has_next) break;
#pragma unroll
        for (int a = 0; a < 2; ++a)
#pragma unroll
            for (int b = 0; b < 2; ++b)
#pragma unroll
                for (int m = 0; m < 4; ++m)
#pragma unroll
                    for (int n = 0; n < 2; ++n) acc[a][b][m][n] = (f32x4){0.f, 0.f, 0.f, 0.f};
        cur = nxt; cA = nA; cB = nB; ++ui;
        if constexpr (ALIGN_EPI) { if (wr == 1) PG8_BAR; }
    }
    PG8_WAIT_V(0);
    if constexpr (!ALIGN_EPI) { if (wr == 0) PG8_BAR; }
    PG8_BAR;
#undef PG8_SA
#undef PG8_SB
#undef PG8_STAGE
#undef PG8_LDA
#undef PG8_LDB
#undef PG8_MMA
#undef PG8_WAIT_V
#undef PG8_WAIT_L
#undef PG8_BAR
#undef PG8_SCHED
}
}

#ifndef PG8_SP2
#define PG8_SP2 true
#endif
#ifndef PG8_ALIGN
#define PG8_ALIGN true
#endif

constexpr int NWAVES = 8;
#ifndef MK_N_LAUNCHES
#define MK_N_LAUNCHES 1
#endif
constexpr int NPH = 15;
constexpr bool ONE_LAUNCH = (MK_N_LAUNCHES == 1);

constexpr int BATCH = 2, SEQ = 8192, D = 4096, M = BATCH * SEQ;
constexpr int HW = 2048, NH = 16, HD = 128, NKV = 4, DFF = 16384, PLE = 256;
constexpr int NIN = 21504;
constexpr int NP2 = 10240, C2_HG = 0, C2_GA = 2048, C2_GB = 6144;
constexpr float EPS = 1e-6f;

constexpr size_t MiB = 1u << 20;
constexpr size_t WS_CTL = 0, CTL_ZERO_BYTES = 1 * MiB;
constexpr size_t WS_LB = 1 * MiB;
constexpr size_t WS_ROPE = 2 * MiB;
constexpr size_t WS_SS = 6 * MiB;
constexpr size_t WS_PBF = 10 * MiB;
constexpr size_t WS_WIN = 18 * MiB;
constexpr size_t WS_WHP = 186 * MiB, WS_WAP = 202 * MiB, WS_WOUT = 218 * MiB, WS_WUP = 250 * MiB, WS_WDN = 378 * MiB, WS_WPLE = 506 * MiB, WS_WPG = 508 * MiB;
constexpr size_t WS_XN = 540 * MiB;
constexpr size_t WS_PROJ = 668 * MiB;
constexpr size_t WS_SQ = WS_PROJ, WS_SFF = WS_PROJ + 64 * MiB, WS_SFB = WS_PROJ + 128 * MiB, WS_SV = WS_PROJ + 192 * MiB;
constexpr size_t WS_ATQ = WS_PROJ + 256 * MiB, WS_ATK = WS_PROJ + 320 * MiB, WS_ATV = WS_PROJ + 336 * MiB, WS_P2 = WS_PROJ + 352 * MiB;
constexpr size_t WS_END = 1340 * MiB;
constexpr size_t WS_OF = WS_WIN, WS_OB = WS_WIN + 64 * MiB, WS_MIX = WS_WIN;
constexpr size_t WS_Y = WS_PROJ;
constexpr size_t WS_SEND = 146 * MiB, WS_DTOT = 162 * MiB;
constexpr size_t WS_U = WS_PROJ, WS_E = WS_PROJ, WS_V = WS_PROJ + 128 * MiB;
constexpr int CW_TMO = 0, CW_CODE = 1;
constexpr int CW_BAR = 4096;

constexpr int RING_OFF = 0, RING_BYTES = 131072;
constexpr int LDSCTL_OFF = RING_BYTES, MISC_OFF = LDSCTL_OFF + 320;
constexpr int LDS_BYTES = 147456;

#define GAS __attribute__((address_space(1)))
#define LAS __attribute__((address_space(3)))
typedef unsigned short bf16;
typedef unsigned v4u __attribute__((ext_vector_type(4)));
typedef unsigned v2u __attribute__((ext_vector_type(2)));
typedef float f32x4 __attribute__((ext_vector_type(4)));
typedef float f32x2 __attribute__((ext_vector_type(2)));
typedef GAS unsigned gu32;
#define RLX_AGENT __ATOMIC_RELAXED, __HIP_MEMORY_SCOPE_AGENT
#define LDS_WAIT() asm volatile("s_waitcnt lgkmcnt(0)" ::: "memory")
#define VM_WAIT() asm volatile("s_waitcnt vmcnt(0)" ::: "memory")
__device__ __forceinline__ size_t tiled_off(int r, int k, int Kt) { return ((size_t)((r >> 8) * (Kt >> 6) + (k >> 6)) * 256 + (r & 255)) * 64 + (k & 63); }
__device__ __forceinline__ unsigned f2bf(float f) { unsigned u = __builtin_bit_cast(unsigned, f); return (u + 0x7fffu + ((u >> 16) & 1u)) >> 16; }
__device__ __forceinline__ unsigned pk2(float lo, float hi) { return f2bf(lo) | (f2bf(hi) << 16); }
__device__ __forceinline__ float bf2f(bf16 b) { return __uint_as_float((unsigned)b << 16); }
__device__ __forceinline__ float blo(unsigned w) { return __uint_as_float(w << 16); }
__device__ __forceinline__ float bhi(unsigned w) { return __uint_as_float(w & 0xffff0000u); }

#define XB_TMO      128
#define XB_XCNT(j)  (256  + 64 * (j))
#define XB_XSUB(j)  (1280 + 64 * (j))
#define XB_XGEN(j)  (2304 + 64 * (j))
#define XB_TOP      3328
#define XB_TOPGEN   3392
#define XCD_BAR_WORDS 3456
#define XB_SPIN_CAP (1u << 18)

__device__ __forceinline__ unsigned xb_ld(unsigned* p)              { return __hip_atomic_load(p, __ATOMIC_RELAXED, __HIP_MEMORY_SCOPE_AGENT); }
__device__ __forceinline__ unsigned xb_add(unsigned* p, unsigned v) { return __hip_atomic_fetch_add(p, v, __ATOMIC_RELAXED, __HIP_MEMORY_SCOPE_AGENT); }
__device__ __forceinline__ unsigned xb_xcc_id() { return (unsigned)__builtin_amdgcn_s_getreg((3 << 11) | 20) & 0xFu; }
#define XB_SPIN(cond, bar) do { unsigned _sp = 0; while (cond) { __builtin_amdgcn_s_sleep(1); \
    if ((++_sp & 255u) == 0u) { if (xb_ld(&(bar)[XB_TMO])) break; if (_sp > XB_SPIN_CAP) { atomicAdd(&(bar)[XB_TMO], 1u); break; } } } } while (0)

struct XcdBarrier { unsigned* bar; unsigned x; volatile LAS unsigned* st; };

__device__ __forceinline__ XcdBarrier xcd_barrier_post(unsigned* bar, volatile LAS unsigned* st) {
    XcdBarrier b; b.bar = bar; b.x = xb_xcc_id(); b.st = st;
    if (threadIdx.x == 0) (void)xb_add(&bar[XB_XCNT(b.x)], 1u);
    return b;
}
__device__ __forceinline__ void xcd_barrier_complete(unsigned* bar, unsigned x, unsigned& nloc, unsigned& nx) {
    const unsigned G = gridDim.x * gridDim.y * gridDim.z;
    unsigned sum, cnt, mine, sp = 0u;
    for (;;) {
        sum = 0u; cnt = 0u; mine = 0u;
#pragma unroll
        for (unsigned j = 0; j < 16; ++j) { const unsigned c = xb_ld(&bar[XB_XCNT(j)]); sum += c; cnt += (c > 0u) ? 1u : 0u; mine = (j == x) ? c : mine; }
        if (sum == G) break;
        __builtin_amdgcn_s_sleep(1);
        if ((++sp & 255u) == 0u) { if (xb_ld(&bar[XB_TMO])) break; if (sp > XB_SPIN_CAP) { atomicAdd(&bar[XB_TMO], 1u); break; } }
    }
    nloc = mine > 0u ? mine : 1u; nx = cnt > 0u ? cnt : 1u;
}
__device__ __forceinline__ void xcd_barrier(const XcdBarrier& b) {
    asm volatile("s_waitcnt vmcnt(0)" ::: "memory");
    __syncthreads();
    if (threadIdx.x == 0) {
        unsigned* bar = b.bar;
        __builtin_amdgcn_s_waitcnt(0);
        unsigned nloc = b.st[0], nx = b.st[1];
        if (nloc == 0u) { xcd_barrier_complete(bar, b.x, nloc, nx); b.st[0] = nloc; b.st[1] = nx; }
        const unsigned old = xb_add(&bar[XB_XSUB(b.x)], 1u);
        const unsigned gen = old / nloc;
        if (old + 1u == (gen + 1u) * nloc) {
            __builtin_amdgcn_fence(__ATOMIC_RELEASE, "agent");
            asm volatile("s_waitcnt vmcnt(0)" ::: "memory");
            const unsigned og = xb_add(&bar[XB_TOP], 1u);
            const unsigned tg = og / nx;
            if (og + 1u == (tg + 1u) * nx) xb_add(&bar[XB_TOPGEN], 1u);
            else XB_SPIN(xb_ld(&bar[XB_TOPGEN]) == tg, bar);
            __builtin_amdgcn_fence(__ATOMIC_ACQUIRE, "agent");
            xb_add(&bar[XB_XGEN(b.x)], 1u);
            asm volatile("s_waitcnt vmcnt(0)" ::: "memory");
        } else {
            XB_SPIN(xb_ld(&bar[XB_XGEN(b.x)]) == gen, bar);
            __builtin_amdgcn_fence(__ATOMIC_ACQUIRE, "agent");
            asm volatile("s_waitcnt vmcnt(0)" ::: "memory");
        }
    }
    __syncthreads();
}

struct Frame {
    LAS unsigned char* lds;
    volatile LAS unsigned* MISC;
    gu32* ctl;
    int tid, lane, wave;
    int vcu, G;
    const float* in[19];
    float* out;
    unsigned char* ws;
};
__device__ __forceinline__ float wave_sum(float v) {
#pragma unroll
    for (int o = 1; o < 64; o <<= 1) v += __shfl_xor(v, o);
    return v;
}
__device__ __forceinline__ float wave_max(float v) {
#pragma unroll
    for (int o = 1; o < 64; o <<= 1) v = fmaxf(v, __shfl_xor(v, o));
    return v;
}

__device__ const double INV_FREQ[64] = {
1.0, 0.8659643233600653, 0.7498942093324559, 0.6493816315762113, 0.5623413251903491, 0.4869675251658631, 0.4216965034285822, 0.3651741272548377, 0.31622776601683794, 0.27384196342643613, 0.23713737056616552, 0.2053525026457146, 0.1778279410038923, 0.1539926526059492, 0.1333521432163324, 0.11547819846894582, 0.1, 0.08659643233600653, 0.07498942093324558, 0.06493816315762113, 0.05623413251903491, 0.04869675251658631, 0.042169650342858224, 0.03651741272548377, 0.03162277660168379, 0.027384196342643614, 0.023713737056616554, 0.02053525026457146, 0.01778279410038923, 0.01539926526059492, 0.01333521432163324, 0.011547819846894581, 0.01, 0.008659643233600654, 0.007498942093324558, 0.006493816315762113, 0.005623413251903491, 0.004869675251658631, 0.004216965034285823, 0.003651741272548377, 0.0031622776601683794, 0.0027384196342643613, 0.0023713737056616554, 0.002053525026457146, 0.0017782794100389228, 0.001539926526059492, 0.001333521432163324, 0.0011547819846894581, 0.001, 0.0008659643233600654, 0.0007498942093324559, 0.0006493816315762113, 0.0005623413251903491, 0.0004869675251658631, 0.00042169650342858224, 0.0003651741272548377, 0.00031622776601683794, 0.0002738419634264361, 0.00023713737056616554, 0.0002053525026457146, 0.00017782794100389227, 0.0001539926526059492, 0.0001333521432163324, 0.00011547819846894582};

__device__ __forceinline__ void p0_transpose_item(const float* W, int K, int N, bf16* WT, LAS float* scr, int item, int lane) {
    const int nblk = N / 32, kb = item / nblk, nb = item % nblk, k0 = 64 * kb, n0 = 32 * nb;
    f32x4 v[8];
#pragma unroll
    for (int i = 0; i < 8; ++i) v[i] = *(const GAS f32x4*)(W + (size_t)(k0 + (lane >> 3) + 8 * i) * N + n0 + 4 * (lane & 7));
#pragma unroll
    for (int i = 0; i < 8; ++i) { const int kk = (lane >> 3) + 8 * i; LAS float* d = scr + (4 * (lane & 7)) * 68 + kk; d[0] = v[i].x; d[68] = v[i].y; d[2 * 68] = v[i].z; d[3 * 68] = v[i].w; }
    LDS_WAIT(); asm volatile("" ::: "memory");
    const int c = lane & 7;
#pragma unroll
    for (int j = 0; j < 4; ++j) { const int n = (lane >> 3) + 8 * j; const LAS f32x4* s = (const LAS f32x4*)(scr + n * 68 + 8 * c); const f32x4 a = s[0], bq = s[1];
        v4u o; o.x = pk2(a.x, a.y); o.y = pk2(a.z, a.w); o.z = pk2(bq.x, bq.y); o.w = pk2(bq.z, bq.w);
        const int nn = n0 + n, kg = k0 + 8 * c;
        *(GAS v4u*)(WT + ((size_t)((nn >> 8) * (K >> 6) + (kg >> 6)) * 256 + (nn & 255)) * 64 + (kg & 63)) = o; }
    LDS_WAIT(); asm volatile("" ::: "memory");
}
__device__ __forceinline__ void rms_row_to_bf16(int lane, const float* xrow, const float* w, bf16* orow, int m) {
    const GAS f32x4* xr = (const GAS f32x4*)xrow + lane;
    f32x4 v[16]; float s = 0.f;
#pragma unroll
    for (int j = 0; j < 16; ++j) { v[j] = xr[64 * j]; s += (v[j].x * v[j].x + v[j].y * v[j].y) + (v[j].z * v[j].z + v[j].w * v[j].w); }
    const float rstd = 1.f / sqrtf(wave_sum(s) * (1.f / D) + EPS);
    const GAS f32x4* wr = (const GAS f32x4*)w + lane;
#pragma unroll
    for (int j = 0; j < 16; ++j) { const f32x4 g = wr[64 * j]; v2u o; o.x = pk2(v[j].x * rstd * g.x, v[j].y * rstd * g.y); o.y = pk2(v[j].z * rstd * g.z, v[j].w * rstd * g.w);
        *(GAS v2u*)(orow + tiled_off(m, 4 * lane + 256 * j, D)) = o; }
}

__device__ __forceinline__ void p0_prologue(Frame& F) {
    LAS float* scr = (LAS float*)(F.lds + RING_OFF + F.wave * 16384);
    const int gw = F.vcu * NWAVES + F.wave, NGW = F.G * NWAVES;
    constexpr int I_IN = (D / 64) * (NIN / 32), I_HP = (HW / 64) * (D / 32), I_AP = I_HP, I_OUT = (D / 64) * (D / 32), I_UP = (D / 64) * (DFF / 32), I_DN = (DFF / 64) * (D / 32), I_PLE = (PLE / 64) * (D / 32), I_PG = I_OUT;
    constexpr int NITEMS = I_IN + I_HP + I_AP + I_OUT + I_UP + I_DN + I_PLE + I_PG;
    unsigned char* ws = F.ws;
    for (int it = gw; it < NITEMS; it += NGW) {
        int r = it;
        if (r < I_IN) { p0_transpose_item(F.in[4], D, NIN, (bf16*)(ws + WS_WIN), scr, r, F.lane); continue; } r -= I_IN;
        if (r < I_HP) { p0_transpose_item(F.in[9], HW, D, (bf16*)(ws + WS_WHP), scr, r, F.lane); continue; } r -= I_HP;
        if (r < I_AP) { p0_transpose_item(F.in[10], HW, D, (bf16*)(ws + WS_WAP), scr, r, F.lane); continue; } r -= I_AP;
        if (r < I_OUT) { p0_transpose_item(F.in[11], D, D, (bf16*)(ws + WS_WOUT), scr, r, F.lane); continue; } r -= I_OUT;
        if (r < I_UP) { p0_transpose_item(F.in[14], D, DFF, (bf16*)(ws + WS_WUP), scr, r, F.lane); continue; } r -= I_UP;
        if (r < I_DN) { p0_transpose_item(F.in[15], DFF, D, (bf16*)(ws + WS_WDN), scr, r, F.lane); continue; } r -= I_DN;
        if (r < I_PLE) { p0_transpose_item(F.in[16], PLE, D, (bf16*)(ws + WS_WPLE), scr, r, F.lane); continue; } r -= I_PLE;
        p0_transpose_item(F.in[17], D, D, (bf16*)(ws + WS_WPG), scr, r, F.lane);
    }
    for (int m = gw; m < M; m += NGW) rms_row_to_bf16(F.lane, F.in[0] + (size_t)m * D, F.in[2], (bf16*)(ws + WS_XN), m);
    { const GAS f32x4* p4 = (const GAS f32x4*)F.in[1]; GAS v2u* o = (GAS v2u*)(ws + WS_PBF);
      for (size_t i = (size_t)gw * 64 + F.lane; i < (size_t)M * PLE / 4; i += (size_t)NGW * 64) { const f32x4 v = p4[i]; v2u w; w.x = pk2(v.x, v.y); w.y = pk2(v.z, v.w);
          *(GAS v2u*)((bf16*)o + tiled_off((int)(i >> 6), (int)(i & 63) * 4, PLE)) = w; } }
    { float* ct = (float*)(ws + WS_ROPE); float* st = ct + SEQ * 64;
      for (int i = gw * 64 + F.lane; i < SEQ * 64; i += NGW * 64) {
          const int pos = i >> 6, fi = i & 63;
          const double x = (double)pos * INV_FREQ[fi];
          const double k = __builtin_rint(x * 0.63661977236758134308);
          double r = __builtin_fma(-k, 1.57079632679489655800e+00, x); r = __builtin_fma(-k, 6.12323399573676603587e-17, r);
          const double r2 = r * r;
          double sp = -1.0 / 1307674368000.0; sp = sp * r2 + 1.0 / 6227020800.0; sp = sp * r2 - 1.0 / 39916800.0; sp = sp * r2 + 1.0 / 362880.0; sp = sp * r2 - 1.0 / 5040.0; sp = sp * r2 + 1.0 / 120.0; sp = sp * r2 - 1.0 / 6.0; sp = sp * r2 + 1.0;
          const double sn = sp * r;
          double cp = 1.0 / 20922789888000.0; cp = cp * r2 - 1.0 / 87178291200.0; cp = cp * r2 + 1.0 / 479001600.0; cp = cp * r2 - 1.0 / 3628800.0; cp = cp * r2 + 1.0 / 40320.0; cp = cp * r2 - 1.0 / 720.0; cp = cp * r2 + 1.0 / 24.0; cp = cp * r2 - 0.5; cp = cp * r2 + 1.0;
          const int q = (int)((long long)k & 3);
          const double cs = (q == 0) ? cp : (q == 1) ? -sn : (q == 2) ? -cp : sn;
          const double ss = (q == 0) ? sn : (q == 1) ? cp : (q == 2) ? -sn : -cp;
          ct[i] = (float)cs; st[i] = (float)ss;
      } }
    { float* lbf = (float*)(ws + WS_LB); float* lbb = lbf + HW;
      for (int i = gw * 64 + F.lane; i < 2 * HW; i += NGW * 64) {
          const float* src = (i < HW) ? F.in[5] : F.in[6]; const int c = (i < HW) ? i : i - HW;
          const float a = src[c], b = src[HW + c];
          const float l = 1.f / (1.f + expf(b - a));
          if (i < HW) lbf[c] = l; else lbb[c] = l;
      } }
}

namespace att {
typedef float f32x16 __attribute__((ext_vector_type(16)));
typedef short bf16x8 __attribute__((ext_vector_type(8)));
typedef short s16x4 __attribute__((ext_vector_type(4)));
typedef short v4i16_t __attribute__((ext_vector_type(4)));
constexpr int KST = 272, VST = 320;
constexpr int KBYTES = 64 * KST, VBYTES = 64 * VST, BUFB = KBYTES + VBYTES;
constexpr float SCL = 0.08838834764831845f * 1.4426950408889634f;
__device__ __forceinline__ s16x4 vtr(const LAS unsigned char* p) { return __builtin_bit_cast(s16x4, __builtin_amdgcn_ds_read_tr16_b64_v4i16((LAS v4i16_t*)p)); }
__device__ __forceinline__ bf16x8 pack8(const float* v) { v4u r; r.x = pg8::cvt_pk_bf16(v[0], v[1]); r.y = pg8::cvt_pk_bf16(v[2], v[3]); r.z = pg8::cvt_pk_bf16(v[4], v[5]); r.w = pg8::cvt_pk_bf16(v[6], v[7]); return __builtin_bit_cast(bf16x8, r); }
struct Pre { v4u k1, k2, v1, v2; f32x4 c0, c1, s0, s1; };
__device__ __forceinline__ void load_tile(Pre& P, const bf16* proj, const float* ct, const float* st, int b, int kvh, int j0, int tid) {
    const int key = tid >> 3, cp = tid & 7, j = j0 + key;
    const size_t ro = ((size_t)(b * NKV + kvh) * SEQ + j) * 128 + 8 * cp;
    const bf16* kr = proj + (WS_ATK - WS_PROJ) / 2 + ro; const bf16* vr = proj + (WS_ATV - WS_PROJ) / 2 + ro;
    P.k1 = *(const GAS v4u*)(kr); P.k2 = *(const GAS v4u*)(kr + 64);
    P.v1 = *(const GAS v4u*)(vr); P.v2 = *(const GAS v4u*)(vr + 64);
    P.c0 = *(const GAS f32x4*)(ct + j * 64 + 8 * cp); P.c1 = *(const GAS f32x4*)(ct + j * 64 + 8 * cp + 4);
    P.s0 = *(const GAS f32x4*)(st + j * 64 + 8 * cp); P.s1 = *(const GAS f32x4*)(st + j * 64 + 8 * cp + 4);
}
__device__ __forceinline__ void rot8(v4u a, v4u b, f32x4 c0, f32x4 c1, f32x4 s0, f32x4 s1, v4u& y1, v4u& y2) {
    const float x1[8] = {blo(a.x), bhi(a.x), blo(a.y), bhi(a.y), blo(a.z), bhi(a.z), blo(a.w), bhi(a.w)};
    const float x2[8] = {blo(b.x), bhi(b.x), blo(b.y), bhi(b.y), blo(b.z), bhi(b.z), blo(b.w), bhi(b.w)};
    const float c[8] = {c0.x, c0.y, c0.z, c0.w, c1.x, c1.y, c1.z, c1.w}, s[8] = {s0.x, s0.y, s0.z, s0.w, s1.x, s1.y, s1.z, s1.w};
    float r1[8], r2[8];
#pragma unroll
    for (int j = 0; j < 8; ++j) { r1[j] = x1[j] * c[j] - x2[j] * s[j]; r2[j] = x2[j] * c[j] + x1[j] * s[j]; }
    y1.x = pg8::cvt_pk_bf16(r1[0], r1[1]); y1.y = pg8::cvt_pk_bf16(r1[2], r1[3]); y1.z = pg8::cvt_pk_bf16(r1[4], r1[5]); y1.w = pg8::cvt_pk_bf16(r1[6], r1[7]);
    y2.x = pg8::cvt_pk_bf16(r2[0], r2[1]); y2.y = pg8::cvt_pk_bf16(r2[2], r2[3]); y2.z = pg8::cvt_pk_bf16(r2[4], r2[5]); y2.w = pg8::cvt_pk_bf16(r2[6], r2[7]);
}
__device__ __forceinline__ void store_tile(const Pre& P, LAS unsigned char* buf, int tid) {
    const int key = tid >> 3, cp = tid & 7;
    v4u y1, y2; rot8(P.k1, P.k2, P.c0, P.c1, P.s0, P.s1, y1, y2);
    *(LAS v4u*)(buf + key * KST + 16 * cp) = y1; *(LAS v4u*)(buf + key * KST + 128 + 16 * cp) = y2;
    *(LAS v4u*)(buf + KBYTES + key * VST + 16 * cp) = P.v1; *(LAS v4u*)(buf + KBYTES + key * VST + 128 + 16 * cp) = P.v2;
}
__device__ __forceinline__ void attn_unit(Frame& F, int u) {
    const int tid = F.tid, lane = F.lane, w = F.wave;
    const int qb = u & 127, kvh = (u >> 7) & 3, b = u >> 9;
    const int q0 = qb * 64, g = w >> 1, rh = w & 1, hh = kvh * 4 + g;
    const int ql = lane & 31, h = lane >> 5, rr = 32 * rh + ql, irow = q0 + rr;
    const bf16* proj = (const bf16*)(F.ws + WS_PROJ);
    const float* ct = (const float*)(F.ws + WS_ROPE); const float* st = ct + SEQ * 64;
    LAS unsigned char* lds = F.lds + RING_OFF;
    const int tlo = (q0 >= 128) ? 0 : ((q0 >= 64) ? 1 : 2), thi = (q0 + 192 <= SEQ) ? 4 : ((q0 + 128 <= SEQ) ? 3 : 2);
    Pre P;
    load_tile(P, proj, ct, st, b, kvh, q0 - 128 + 64 * tlo, tid);
    bf16x8 qf[8];
    { const bf16* qrow = proj + (WS_ATQ - WS_PROJ) / 2 + ((size_t)(b * NH + hh) * SEQ + irow) * 128;
#pragma unroll
      for (int ks = 0; ks < 4; ++ks) {
          const v4u a = *(const GAS v4u*)(qrow + 16 * ks + 8 * h), bb = *(const GAS v4u*)(qrow + 64 + 16 * ks + 8 * h);
          const float* cp_ = ct + irow * 64 + 16 * ks + 8 * h; const float* sp_ = st + irow * 64 + 16 * ks + 8 * h;
          v4u y1, y2; rot8(a, bb, *(const GAS f32x4*)cp_, *(const GAS f32x4*)(cp_ + 4), *(const GAS f32x4*)sp_, *(const GAS f32x4*)(sp_ + 4), y1, y2);
          qf[ks] = __builtin_bit_cast(bf16x8, y1); qf[ks + 4] = __builtin_bit_cast(bf16x8, y2);
      } }
    const float sinkL = F.in[8][hh] * 1.4426950408889634f;
    float mrun = sinkL, lrun = (h == 0) ? 1.f : 0.f;
    f32x16 O[4];
#pragma unroll
    for (int dt = 0; dt < 4; ++dt)
#pragma unroll
        for (int r = 0; r < 16; ++r) O[dt][r] = 0.f;
    store_tile(P, lds + (tlo & 1) * BUFB, tid);
    __syncthreads();
    const int q4 = (lane & 15) >> 2, p4 = lane & 3, dblk = (lane >> 4) & 1;
    for (int t = tlo; t <= thi; ++t) {
        const LAS unsigned char* Kb = lds + (t & 1) * BUFB; const LAS unsigned char* Vb = Kb + KBYTES;
        if (t < thi) load_tile(P, proj, ct, st, b, kvh, q0 - 128 + 64 * (t + 1), tid);
        f32x16 sT[2];
#pragma unroll
        for (int kt = 0; kt < 2; ++kt) {
#pragma unroll
            for (int r = 0; r < 16; ++r) sT[kt][r] = 0.f;
#pragma unroll
            for (int ks = 0; ks < 8; ++ks) {
                const bf16x8 kf = *(const LAS bf16x8*)(Kb + (32 * kt + ql) * KST + (16 * ks + 8 * h) * 2);
                sT[kt] = __builtin_amdgcn_mfma_f32_32x32x16_bf16(kf, qf[ks], sT[kt], 0, 0, 0);
            }
        }
        float tmax = -INFINITY;
#pragma unroll
        for (int kt = 0; kt < 2; ++kt)
#pragma unroll
            for (int r = 0; r < 16; ++r) {
                const int kk = 32 * kt + (r & 3) + 8 * (r >> 2) + 4 * h;
                float v = sT[kt][r] * SCL;
                if (t == 0 && kk < rr) v = -INFINITY;
                if (t == 4 && kk > rr) v = -INFINITY;
                sT[kt][r] = v; tmax = fmaxf(tmax, v);
            }
        tmax = fmaxf(tmax, __shfl_xor(tmax, 32));
        const float mnew = fmaxf(mrun, tmax), alpha = __builtin_amdgcn_exp2f(mrun - mnew);
        mrun = mnew; lrun *= alpha;
        if (!__all(alpha == 1.f)) {
#pragma unroll
            for (int dt = 0; dt < 4; ++dt)
#pragma unroll
                for (int r = 0; r < 16; ++r) O[dt][r] *= alpha;
        }
        bf16x8 pf[2][2];
#pragma unroll
        for (int kt = 0; kt < 2; ++kt) {
            float pv[16];
#pragma unroll
            for (int r = 0; r < 16; ++r) { pv[r] = __builtin_amdgcn_exp2f(sT[kt][r] - mnew); lrun += pv[r]; }
            pf[kt][0] = pack8(pv); pf[kt][1] = pack8(pv + 8);
        }
#pragma unroll
        for (int dt = 0; dt < 4; ++dt)
#pragma unroll
            for (int kt = 0; kt < 2; ++kt)
#pragma unroll
                for (int s2 = 0; s2 < 2; ++s2) {
                    const LAS unsigned char* a = Vb + (32 * kt + 16 * s2 + 4 * h + q4) * VST + (32 * dt + 16 * dblk + 4 * p4) * 2;
                    const s16x4 lo = vtr(a), hi = vtr(a + 8 * VST);
                    const bf16x8 vf = __builtin_shufflevector(lo, hi, 0, 1, 2, 3, 4, 5, 6, 7);
                    O[dt] = __builtin_amdgcn_mfma_f32_32x32x16_bf16(vf, pf[kt][s2], O[dt], 0, 0, 0);
                }
        if (t < thi) store_tile(P, lds + ((t + 1) & 1) * BUFB, tid);
        __syncthreads();
    }
    const float ltot = lrun + __shfl_xor(lrun, 32), inv = 1.f / ltot;
    bf16* xnb = (bf16*)(F.ws + WS_XN); const int orow_m = b * SEQ + irow, ocol0 = HW + hh * 128;
#pragma unroll
    for (int dt = 0; dt < 4; ++dt)
#pragma unroll
        for (int rg = 0; rg < 4; ++rg) {
            v2u o; o.x = pg8::cvt_pk_bf16(O[dt][4 * rg] * inv, O[dt][4 * rg + 1] * inv); o.y = pg8::cvt_pk_bf16(O[dt][4 * rg + 2] * inv, O[dt][4 * rg + 3] * inv);
            *(GAS v2u*)(xnb + tiled_off(orow_m, ocol0 + 32 * dt + 8 * rg + 4 * h, D)) = o;
        }
}
}

namespace scn {
using att::f32x16; using att::bf16x8; using att::s16x4; using att::vtr; using att::pack8;
constexpr int QST = 272, TST = 320;
constexpr int QH_OFF = 0, KH_OFF = 64 * QST, KT_OFF = KH_OFF + 64 * QST, VV_OFF = KT_OFF + 64 * TST, ST_OFF = VV_OFF + 64 * TST, DEC_OFF = ST_OFF + 128 * QST, TOT_OFF = DEC_OFF + 512, FLAG_OFF = TOT_OFF + 8 * 128 * 4, END_OFF = FLAG_OFF + 16;
static_assert(END_OFF <= RING_BYTES, "scan LDS map");
struct Raw { v4u q1, q2, s1, s2, v1, v2; };
__device__ __forceinline__ void load_raw(Raw& R, const bf16* proj, int b, int h, int dir, int n, int tid) {
    const int i = tid >> 3, cp = tid & 7, tau = 64 * n + i, t = dir ? (SEQ - 1 - tau) : tau;
    const bf16* row = proj + ((size_t)(b * NH + h) * SEQ + t) * 128 + 8 * cp;
    const size_t C_HQ = (WS_SQ - WS_PROJ) / 2, C_HI = (WS_SV - WS_PROJ) / 2;
    const size_t cf = (dir ? (WS_SFB - WS_PROJ) : (WS_SFF - WS_PROJ)) / 2;
    R.q1 = *(const GAS v4u*)(row + C_HQ); R.q2 = *(const GAS v4u*)(row + C_HQ + 64);
    R.s1 = *(const GAS v4u*)(row + cf); R.s2 = *(const GAS v4u*)(row + cf + 64);
    R.v1 = *(const GAS v4u*)(row + C_HI); R.v2 = *(const GAS v4u*)(row + C_HI + 64);
}
__device__ __forceinline__ void store_raw(const Raw& R, LAS unsigned char* lds, int tid) {
    const int i = tid >> 3, cp = tid & 7;
    *(LAS v4u*)(lds + QH_OFF + i * QST + 16 * cp) = R.q1; *(LAS v4u*)(lds + QH_OFF + i * QST + 128 + 16 * cp) = R.q2;
    *(LAS v4u*)(lds + KH_OFF + i * QST + 16 * cp) = R.s1; *(LAS v4u*)(lds + KH_OFF + i * QST + 128 + 16 * cp) = R.s2;
    *(LAS v4u*)(lds + VV_OFF + i * TST + 16 * cp) = R.v1; *(LAS v4u*)(lds + VV_OFF + i * TST + 128 + 16 * cp) = R.v2;
}
struct Ctx { LAS unsigned char* lds; const bf16* proj; bf16* Og; int b, hd, dir, tid, ct, vt, ql, h, q4, p4, dblk, kp, sg, nend; float oml0, oml1; };
#define LBAR() do { asm volatile("s_waitcnt lgkmcnt(0)" ::: "memory"); __builtin_amdgcn_s_barrier(); asm volatile("" ::: "memory"); } while (0)
__device__ __forceinline__ void scan_step(const Ctx& C, f32x16 (&S)[2], float (&DT)[2], const Raw& Rst, Raw& Rld, const int n) {
    LAS unsigned char* lds = C.lds; const bf16* proj = C.proj; bf16* Og = C.Og;
    const int b = C.b, hd = C.hd, dir = C.dir, tid = C.tid, ct = C.ct, vt = C.vt, ql = C.ql, h = C.h, q4 = C.q4, p4 = C.p4, dblk = C.dblk, kp = C.kp, sg = C.sg;
    const float oml0 = C.oml0, oml1 = C.oml1;
        float qv0[8], qv1[8], kk0[8], kk1[8], pp0[8], pp1[8];
        { float run0 = 1.f, run1 = 1.f;
#pragma unroll
          for (int ii = 0; ii < 8; ++ii) {
              const int i = 8 * sg + ii;
              const unsigned qr = *(const LAS unsigned*)(lds + QH_OFF + i * QST + 4 * kp), sr = *(const LAS unsigned*)(lds + KH_OFF + i * QST + 4 * kp);
              qv0[ii] = blo(qr); qv1[ii] = bhi(qr);
              kk0[ii] = oml0 * blo(sr); kk1[ii] = oml1 * bhi(sr);
              run0 *= (1.f - kk0[ii]); run1 *= (1.f - kk1[ii]);
              pp0[ii] = run0; pp1[ii] = run1;
          }
          *(LAS f32x2*)(lds + TOT_OFF + (sg * 128 + 2 * kp) * 4) = (f32x2){run0, run1}; }
        LBAR();
        { float pre0 = 1.f, pre1 = 1.f, all0 = 1.f, all1 = 1.f;
#pragma unroll
          for (int s_ = 0; s_ < 8; ++s_) { const f32x2 T = *(const LAS f32x2*)(lds + TOT_OFF + (s_ * 128 + 2 * kp) * 4); all0 *= T.x; all1 *= T.y; if (s_ < sg) { pre0 *= T.x; pre1 *= T.y; } }
#pragma unroll
          for (int ii = 0; ii < 8; ++ii) {
              const int i = 8 * sg + ii;
              const float P0 = pre0 * pp0[ii], P1 = pre1 * pp1[ii];
              const float r0 = __builtin_amdgcn_rcpf(P0), r1 = __builtin_amdgcn_rcpf(P1);
              const float kh0 = kk0[ii] * r0, kh1 = kk1[ii] * r1;
              *(LAS unsigned*)(lds + QH_OFF + i * QST + 4 * kp) = pg8::cvt_pk_bf16(qv0[ii] * P0, qv1[ii] * P1);
              *(LAS unsigned*)(lds + KH_OFF + i * QST + 4 * kp) = pg8::cvt_pk_bf16(kh0, kh1);
              *(LAS unsigned*)(lds + KT_OFF + i * TST + 4 * kp) = pg8::cvt_pk_bf16(kh0 * all0, kh1 * all1);
          }
          DT[0] *= all0; DT[1] *= all1;
          if (sg == 0) *(LAS f32x2*)(lds + DEC_OFF + 2 * kp * 4) = (f32x2){all0, all1}; }
        LBAR();
        if (n + 2 < C.nend) load_raw(Rld, proj, b, hd, dir, n + 2, tid);
        bf16x8 qa[8], sf[8], kf0[8];
#pragma unroll
        for (int ks = 0; ks < 8; ++ks) qa[ks] = *(const LAS bf16x8*)(lds + QH_OFF + (32 * ct + ql) * QST + (16 * ks + 8 * h) * 2);
#pragma unroll
        for (int ks = 0; ks < 8; ++ks) sf[ks] = *(const LAS bf16x8*)(lds + ST_OFF + (32 * vt + ql) * QST + (16 * ks + 8 * h) * 2);
#pragma unroll
        for (int ks = 0; ks < 8; ++ks) kf0[ks] = *(const LAS bf16x8*)(lds + KH_OFF + ql * QST + (16 * ks + 8 * h) * 2);
        asm volatile("" ::: "memory");
        f32x16 OT;
#pragma unroll
        for (int r = 0; r < 16; ++r) OT[r] = 0.f;
#pragma unroll
        for (int ks = 0; ks < 8; ++ks) OT = __builtin_amdgcn_mfma_f32_32x32x16_bf16(sf[ks], qa[ks], OT, 0, 0, 0);
        {
            const LAS unsigned char* va = lds + VV_OFF + (4 * h + q4) * TST + (32 * vt + 16 * dblk + 4 * p4) * 2;
            const s16x4 v0lo = vtr(va), v0hi = vtr(va + 8 * TST), v1lo = vtr(va + 16 * TST), v1hi = vtr(va + 24 * TST);
            asm volatile("" ::: "memory");
            f32x16 X;
#pragma unroll
            for (int r = 0; r < 16; ++r) X[r] = 0.f;
#pragma unroll
            for (int ks = 0; ks < 8; ++ks) X = __builtin_amdgcn_mfma_f32_32x32x16_bf16(kf0[ks], qa[ks], X, 0, 0, 0);
            float xv[16];
#pragma unroll
            for (int r = 0; r < 16; ++r) { const int sl = (r & 3) + 8 * (r >> 2) + 4 * h; xv[r] = (ct > 0 || sl <= ql) ? X[r] : 0.f; }
            OT = __builtin_amdgcn_mfma_f32_32x32x16_bf16(__builtin_shufflevector(v0lo, v0hi, 0, 1, 2, 3, 4, 5, 6, 7), pack8(xv), OT, 0, 0, 0);
            OT = __builtin_amdgcn_mfma_f32_32x32x16_bf16(__builtin_shufflevector(v1lo, v1hi, 0, 1, 2, 3, 4, 5, 6, 7), pack8(xv + 8), OT, 0, 0, 0);
        }
        if (ct > 0) {
            bf16x8 kf1[8];
#pragma unroll
            for (int ks = 0; ks < 8; ++ks) kf1[ks] = *(const LAS bf16x8*)(lds + KH_OFF + (32 + ql) * QST + (16 * ks + 8 * h) * 2);
            const LAS unsigned char* va = lds + VV_OFF + (32 + 4 * h + q4) * TST + (32 * vt + 16 * dblk + 4 * p4) * 2;
            const s16x4 v0lo = vtr(va), v0hi = vtr(va + 8 * TST), v1lo = vtr(va + 16 * TST), v1hi = vtr(va + 24 * TST);
            asm volatile("" ::: "memory");
            f32x16 X;
#pragma unroll
            for (int r = 0; r < 16; ++r) X[r] = 0.f;
#pragma unroll
            for (int ks = 0; ks < 8; ++ks) X = __builtin_amdgcn_mfma_f32_32x32x16_bf16(kf1[ks], qa[ks], X, 0, 0, 0);
            float xv[16];
#pragma unroll
            for (int r = 0; r < 16; ++r) { const int sl = (r & 3) + 8 * (r >> 2) + 4 * h; xv[r] = (sl <= ql) ? X[r] : 0.f; }
            OT = __builtin_amdgcn_mfma_f32_32x32x16_bf16(__builtin_shufflevector(v0lo, v0hi, 0, 1, 2, 3, 4, 5, 6, 7), pack8(xv), OT, 0, 0, 0);
            OT = __builtin_amdgcn_mfma_f32_32x32x16_bf16(__builtin_shufflevector(v1lo, v1hi, 0, 1, 2, 3, 4, 5, 6, 7), pack8(xv + 8), OT, 0, 0, 0);
        }
        {
            bf16x8 vbf[4], kaf[2][4]; f32x4 d4[2][4];
#pragma unroll
            for (int cs = 0; cs < 4; ++cs) {
                const LAS unsigned char* vb_ = lds + VV_OFF + (16 * cs + 8 * h + q4) * TST + (32 * vt + 16 * dblk + 4 * p4) * 2;
                const s16x4 vlo = vtr(vb_), vhi = vtr(vb_ + 4 * TST);
                vbf[cs] = __builtin_shufflevector(vlo, vhi, 0, 1, 2, 3, 4, 5, 6, 7);
#pragma unroll
                for (int j = 0; j < 2; ++j) {
                    const LAS unsigned char* ka = lds + KT_OFF + (16 * cs + 8 * h + q4) * TST + (32 * (2 * ct + j) + 16 * dblk + 4 * p4) * 2;
                    const s16x4 klo = vtr(ka), khi = vtr(ka + 4 * TST);
                    kaf[j][cs] = __builtin_shufflevector(klo, khi, 0, 1, 2, 3, 4, 5, 6, 7);
                }
            }
#pragma unroll
            for (int j = 0; j < 2; ++j)
#pragma unroll
                for (int rg = 0; rg < 4; ++rg) d4[j][rg] = *(const LAS f32x4*)(lds + DEC_OFF + (32 * (2 * ct + j) + 8 * rg + 4 * h) * 4);
            asm volatile("" ::: "memory");
#pragma unroll
            for (int j = 0; j < 2; ++j)
#pragma unroll
                for (int rg = 0; rg < 4; ++rg) { S[j][4 * rg] *= d4[j][rg].x; S[j][4 * rg + 1] *= d4[j][rg].y; S[j][4 * rg + 2] *= d4[j][rg].z; S[j][4 * rg + 3] *= d4[j][rg].w; }
#pragma unroll
            for (int cs = 0; cs < 4; ++cs)
#pragma unroll
                for (int j = 0; j < 2; ++j) S[j] = __builtin_amdgcn_mfma_f32_32x32x16_bf16(kaf[j][cs], vbf[cs], S[j], 0, 0, 0);
        }
        { const int tau = 64 * n + 32 * ct + ql, t = dir ? (SEQ - 1 - tau) : tau;
          bf16* orow = Og + (size_t)(b * SEQ + t) * HW + hd * 128 + 32 * vt;
#pragma unroll
          for (int rg = 0; rg < 4; ++rg) { v2u o; o.x = pg8::cvt_pk_bf16(OT[4 * rg], OT[4 * rg + 1]); o.y = pg8::cvt_pk_bf16(OT[4 * rg + 2], OT[4 * rg + 3]); *(GAS v2u*)(orow + 8 * rg + 4 * h) = o; } }
        LBAR();
#pragma unroll
        for (int j = 0; j < 2; ++j) {
            const int kt = 2 * ct + j;
#pragma unroll
            for (int rg = 0; rg < 4; ++rg) { v2u o; o.x = pg8::cvt_pk_bf16(S[j][4 * rg], S[j][4 * rg + 1]); o.y = pg8::cvt_pk_bf16(S[j][4 * rg + 2], S[j][4 * rg + 3]);
                *(LAS v2u*)(lds + ST_OFF + (32 * vt + ql) * QST + (32 * kt + 8 * rg + 4 * h) * 2) = o; }
        }
        if (n + 1 < C.nend) store_raw(Rst, lds, tid);
        LBAR();
}
constexpr int NSEG = 4, SEGC = (SEQ / 64) / NSEG;
__device__ __forceinline__ void scan_unit(Frame& F, int unit) {
    const int seg = unit & (NSEG - 1), bhd = unit >> 2;
    const int b = bhd >> 5, hd = (bhd >> 1) & 15, dir = bhd & 1;
    const int tid = F.tid, lane = F.lane, w = F.wave;
    LAS unsigned char* lds = F.lds + RING_OFF;
    const bf16* proj = (const bf16*)(F.ws + WS_PROJ);
    bf16* Og = (bf16*)(F.ws + (dir ? WS_OB : WS_OF));
    const float* lb = (const float*)(F.ws + WS_LB) + (dir ? HW : 0) + hd * 128;
    const int ct = w >> 2, vt = w & 3, ql = lane & 31, h = lane >> 5;
    const int q4 = (lane & 15) >> 2, p4 = lane & 3, dblk = (lane >> 4) & 1;
    const int kp = lane, sg = w;
    const float oml0 = 1.f - lb[2 * kp], oml1 = 1.f - lb[2 * kp + 1];
    for (int e = tid; e < 128 * QST / 16; e += 512) *(LAS v4u*)(lds + ST_OFF + 16 * e) = (v4u){0u, 0u, 0u, 0u};
    f32x16 S[2];
#pragma unroll
    for (int j = 0; j < 2; ++j)
#pragma unroll
        for (int r = 0; r < 16; ++r) S[j][r] = 0.f;
    float DT[2] = {1.f, 1.f};
    const int n0 = seg * SEGC, n1 = n0 + SEGC;
    Raw RA, RB;
    load_raw(RA, proj, b, hd, dir, n0, tid);
    load_raw(RB, proj, b, hd, dir, n0 + 1, tid);
    store_raw(RA, lds, tid);
    __syncthreads();
    Ctx C; C.lds = lds; C.proj = proj; C.Og = Og; C.b = b; C.hd = hd; C.dir = dir; C.tid = tid; C.ct = ct; C.vt = vt; C.ql = ql; C.h = h; C.q4 = q4; C.p4 = p4; C.dblk = dblk; C.kp = kp; C.sg = sg; C.nend = n1; C.oml0 = oml0; C.oml1 = oml1;
    for (int n = n0; n < n1; n += 2) {
        scan_step(C, S, DT, RB, RA, n);
        scan_step(C, S, DT, RA, RB, n + 1);
    }
    { GAS f32x4* send = (GAS f32x4*)(F.ws + WS_SEND) + (size_t)unit * 4096;
#pragma unroll
      for (int j = 0; j < 2; ++j)
#pragma unroll
          for (int rg = 0; rg < 4; ++rg) send[((w * 2 + j) * 4 + rg) * 64 + lane] = (f32x4){S[j][4 * rg], S[j][4 * rg + 1], S[j][4 * rg + 2], S[j][4 * rg + 3]};
      if (w == 0) *(GAS f32x2*)((float*)(F.ws + WS_DTOT) + unit * 128 + 2 * kp) = (f32x2){DT[0], DT[1]}; }
}
__device__ __forceinline__ void fixup_unit(Frame& F, int unit) {
    const int seg = unit & (NSEG - 1), bhd = unit >> 2;
    const int b = bhd >> 5, hd = (bhd >> 1) & 15, dir = bhd & 1;
    const int tid = F.tid, lane = F.lane, w = F.wave;
    LAS unsigned char* lds = F.lds + RING_OFF;
    const bf16* proj = (const bf16*)(F.ws + WS_PROJ);
    bf16* Og = (bf16*)(F.ws + (dir ? WS_OB : WS_OF));
    const float* lb = (const float*)(F.ws + WS_LB) + (dir ? HW : 0) + hd * 128;
    const int ct = w >> 2, vt = w & 3, ql = lane & 31, h = lane >> 5;
    const int kp = lane, sg = w;
    const float oml0 = 1.f - lb[2 * kp], oml1 = 1.f - lb[2 * kp + 1];
    f32x16 S[2];
    { const GAS f32x4* send = (const GAS f32x4*)(F.ws + WS_SEND) + (size_t)(bhd * NSEG) * 4096;
      const float* dtot = (const float*)(F.ws + WS_DTOT) + (size_t)(bhd * NSEG) * 128;
#pragma unroll
      for (int j = 0; j < 2; ++j)
#pragma unroll
          for (int rg = 0; rg < 4; ++rg) { const f32x4 e = send[((w * 2 + j) * 4 + rg) * 64 + lane]; S[j][4 * rg] = e.x; S[j][4 * rg + 1] = e.y; S[j][4 * rg + 2] = e.z; S[j][4 * rg + 3] = e.w; }
      for (int g = 1; g < seg; ++g) {
#pragma unroll
          for (int j = 0; j < 2; ++j)
#pragma unroll
              for (int rg = 0; rg < 4; ++rg) { const f32x4 e = send[(size_t)g * 4096 + ((w * 2 + j) * 4 + rg) * 64 + lane]; const f32x4 d = *(const GAS f32x4*)(dtot + g * 128 + 32 * (2 * ct + j) + 8 * rg + 4 * h);
                  S[j][4 * rg] = d.x * S[j][4 * rg] + e.x; S[j][4 * rg + 1] = d.y * S[j][4 * rg + 1] + e.y; S[j][4 * rg + 2] = d.z * S[j][4 * rg + 2] + e.z; S[j][4 * rg + 3] = d.w * S[j][4 * rg + 3] + e.w; }
      } }
    float dc0 = 1.f, dc1 = 1.f;
    const int n0 = seg * SEGC, n1 = n0 + SEGC;
    for (int n = n0; n < n1; ++n) {
        __syncthreads();
#pragma unroll
        for (int j = 0; j < 2; ++j) {
            const int kt = 2 * ct + j;
#pragma unroll
            for (int rg = 0; rg < 4; ++rg) { v2u o; o.x = pg8::cvt_pk_bf16(S[j][4 * rg], S[j][4 * rg + 1]); o.y = pg8::cvt_pk_bf16(S[j][4 * rg + 2], S[j][4 * rg + 3]);
                *(LAS v2u*)(lds + ST_OFF + (32 * vt + ql) * QST + (32 * kt + 8 * rg + 4 * h) * 2) = o; }
        }
        { Raw R; load_raw(R, proj, b, hd, dir, n, tid); store_raw(R, lds, tid); }
        __syncthreads();
        float qv0[8], qv1[8], pp0[8], pp1[8];
        { float run0 = 1.f, run1 = 1.f;
#pragma unroll
          for (int ii = 0; ii < 8; ++ii) {
              const int i = 8 * sg + ii;
              const unsigned qr = *(const LAS unsigned*)(lds + QH_OFF + i * QST + 4 * kp), sr = *(const LAS unsigned*)(lds + KH_OFF + i * QST + 4 * kp);
              qv0[ii] = blo(qr); qv1[ii] = bhi(qr);
              run0 *= (1.f - oml0 * blo(sr)); run1 *= (1.f - oml1 * bhi(sr));
              pp0[ii] = run0; pp1[ii] = run1;
          }
          *(LAS f32x2*)(lds + TOT_OFF + (sg * 128 + 2 * kp) * 4) = (f32x2){run0, run1}; }
        __syncthreads();
        { float pre0 = 1.f, pre1 = 1.f, all0 = 1.f, all1 = 1.f;
#pragma unroll
          for (int s_ = 0; s_ < 8; ++s_) { const f32x2 T = *(const LAS f32x2*)(lds + TOT_OFF + (s_ * 128 + 2 * kp) * 4); all0 *= T.x; all1 *= T.y; if (s_ < sg) { pre0 *= T.x; pre1 *= T.y; } }
#pragma unroll
          for (int ii = 0; ii < 8; ++ii) { const int i = 8 * sg + ii;
              *(LAS unsigned*)(lds + QH_OFF + i * QST + 4 * kp) = pg8::cvt_pk_bf16(qv0[ii] * (pre0 * pp0[ii]), qv1[ii] * (pre1 * pp1[ii])); }
          if (sg == 0) { *(LAS f32x2*)(lds + DEC_OFF + 2 * kp * 4) = (f32x2){all0, all1};
              dc0 *= all0; dc1 *= all1;
              const bool any = __any((dc0 != 0.f) || (dc1 != 0.f)) != 0;
              if (lane == 0) *(LAS unsigned*)(lds + FLAG_OFF) = any ? 1u : 0u; } }
        __syncthreads();
        { bf16x8 qa[8], sf[8];
#pragma unroll
          for (int ks = 0; ks < 8; ++ks) qa[ks] = *(const LAS bf16x8*)(lds + QH_OFF + (32 * ct + ql) * QST + (16 * ks + 8 * h) * 2);
#pragma unroll
          for (int ks = 0; ks < 8; ++ks) sf[ks] = *(const LAS bf16x8*)(lds + ST_OFF + (32 * vt + ql) * QST + (16 * ks + 8 * h) * 2);
          f32x16 OT;
#pragma unroll
          for (int r = 0; r < 16; ++r) OT[r] = 0.f;
#pragma unroll
          for (int ks = 0; ks < 8; ++ks) OT = __builtin_amdgcn_mfma_f32_32x32x16_bf16(sf[ks], qa[ks], OT, 0, 0, 0);
          const int tau = 64 * n + 32 * ct + ql, t = dir ? (SEQ - 1 - tau) : tau;
          bf16* orow = Og + (size_t)(b * SEQ + t) * HW + hd * 128 + 32 * vt;
#pragma unroll
          for (int rg = 0; rg < 4; ++rg) { GAS v2u* p = (GAS v2u*)(orow + 8 * rg + 4 * h); const v2u old = *p;
              v2u o; o.x = pg8::cvt_pk_bf16(blo(old.x) + OT[4 * rg], bhi(old.x) + OT[4 * rg + 1]); o.y = pg8::cvt_pk_bf16(blo(old.y) + OT[4 * rg + 2], bhi(old.y) + OT[4 * rg + 3]); *p = o; } }
#pragma unroll
        for (int j = 0; j < 2; ++j)
#pragma unroll
            for (int rg = 0; rg < 4; ++rg) { const f32x4 d4 = *(const LAS f32x4*)(lds + DEC_OFF + (32 * (2 * ct + j) + 8 * rg + 4 * h) * 4);
                S[j][4 * rg] *= d4.x; S[j][4 * rg + 1] *= d4.y; S[j][4 * rg + 2] *= d4.z; S[j][4 * rg + 3] *= d4.w; }
        const unsigned more = *(const LAS unsigned*)(lds + FLAG_OFF);
        if (__builtin_amdgcn_readfirstlane(more) == 0u) break;
    }
    __syncthreads();
}
}

__device__ __forceinline__ void ohnorm_phase(Frame& F) {
    const int gw = F.vcu * NWAVES + F.wave, NGW = F.G * NWAVES, lane = F.lane;
    const bf16* of = (const bf16*)(F.ws + WS_OF); const bf16* ob = (const bf16*)(F.ws + WS_OB);
    const bf16* proj = (const bf16*)(F.ws + WS_PROJ);
    const float* hn = F.in[7] + (lane & 3) * 32;
    for (int m = gw; m < M; m += NGW) {
        const GAS v4u* a = (const GAS v4u*)(of + (size_t)m * HW + lane * 32);
        const GAS v4u* b = (const GAS v4u*)(ob + (size_t)m * HW + lane * 32);
        const GAS v4u* g = (const GAS v4u*)(proj + (WS_P2 - WS_PROJ) / 2 + (size_t)m * NP2 + C2_HG + lane * 32);
        bf16* xnb = (bf16*)(F.ws + WS_XN);
        float v[32]; float ss = 0.f;
#pragma unroll
        for (int q = 0; q < 4; ++q) { const v4u x = a[q], y = b[q];
            v[q * 8 + 0] = blo(x.x) + blo(y.x); v[q * 8 + 1] = bhi(x.x) + bhi(y.x); v[q * 8 + 2] = blo(x.y) + blo(y.y); v[q * 8 + 3] = bhi(x.y) + bhi(y.y);
            v[q * 8 + 4] = blo(x.z) + blo(y.z); v[q * 8 + 5] = bhi(x.z) + bhi(y.z); v[q * 8 + 6] = blo(x.w) + blo(y.w); v[q * 8 + 7] = bhi(x.w) + bhi(y.w); }
#pragma unroll
        for (int j = 0; j < 32; ++j) ss += v[j] * v[j];
        ss += __shfl_xor(ss, 1); ss += __shfl_xor(ss, 2);
        const float rstd = 1.f / sqrtf(ss * (1.f / 128.f) + EPS);
#pragma unroll
        for (int q = 0; q < 4; ++q) { const v4u z = g[q];
            float gg[8] = {blo(z.x), bhi(z.x), blo(z.y), bhi(z.y), blo(z.z), bhi(z.z), blo(z.w), bhi(z.w)};
            float r[8];
#pragma unroll
            for (int j = 0; j < 8; ++j) r[j] = v[q * 8 + j] * rstd * hn[q * 8 + j] * gg[j];
            v4u w; w.x = pk2(r[0], r[1]); w.y = pk2(r[2], r[3]); w.z = pk2(r[4], r[5]); w.w = pk2(r[6], r[7]); *(GAS v4u*)(xnb + tiled_off(m, lane * 32 + 8 * q, D)) = w; }
    }
}

template <int KIND>
__device__ __forceinline__ void resid_phase(Frame& F, const bf16* Y, const float* xin, const bf16* bin, bf16* XB, const float* wpost, const float* wpre) {
    const int gw = F.vcu * NWAVES + F.wave, NGW = F.G * NWAVES, lane = F.lane;
    const float* SS = (const float*)(F.ws + WS_SS);
#pragma nounroll
    for (int m = gw; m < M; m += NGW) {
        const GAS v2u* y2 = (const GAS v2u*)(Y + (size_t)m * D) + lane;
        const GAS f32x4* x4 = (const GAS f32x4*)(xin + (size_t)m * D) + lane;
        const GAS v2u* b2 = (const GAS v2u*)(bin + (size_t)m * D) + lane;
        const GAS f32x4* w4 = (const GAS f32x4*)wpost + lane;
        GAS f32x4* o4 = (GAS f32x4*)(F.out + (size_t)m * D) + lane;
        GAS v2u* xb = (GAS v2u*)(XB + (size_t)m * D) + lane;
        bf16* xnb = (bf16*)(F.ws + WS_XN);
        const float rstd = 1.f / sqrtf(wave_sum(SS[(size_t)m * 64 + lane]) * (1.f / D) + EPS);
        f32x4 v[16]; float s2 = 0.f;
#pragma unroll
        for (int hh = 0; hh < 2; ++hh) {
            v2u yv[8]; f32x4 wv[8];
#pragma unroll
            for (int jj = 0; jj < 8; ++jj) { const int j = 8 * hh + jj; yv[jj] = y2[64 * j]; wv[jj] = w4[64 * j];
                if (KIND == 0) v[j] = x4[64 * j];
                else { const v2u bb = (KIND == 2) ? *(const GAS v2u*)(bin + tiled_off(m, 4 * lane + 256 * j, D)) : b2[64 * j]; v[j] = (f32x4){blo(bb.x), bhi(bb.x), blo(bb.y), bhi(bb.y)}; } }
            asm volatile("" ::: "memory");
#pragma unroll
            for (int jj = 0; jj < 8; ++jj) { const int j = 8 * hh + jj; const v2u y = yv[jj]; const f32x4 w = wv[jj]; const f32x4 x = v[j];
                f32x4 r; r.x = x.x + blo(y.x) * rstd * w.x; r.y = x.y + bhi(y.x) * rstd * w.y; r.z = x.z + blo(y.y) * rstd * w.z; r.w = x.w + bhi(y.y) * rstd * w.w;
                if (KIND == 0) { v[j] = r; s2 += (r.x * r.x + r.y * r.y) + (r.z * r.z + r.w * r.w); v2u o; o.x = pk2(r.x, r.y); o.y = pk2(r.z, r.w); xb[64 * j] = o; }
                if (KIND == 1) { v2u o; o.x = pk2(r.x, r.y); o.y = pk2(r.z, r.w); *(GAS v2u*)(xnb + tiled_off(m, 4 * lane + 256 * j, D)) = o; }
                if (KIND == 2) o4[64 * j] = r; }
        }
        if (KIND == 0) {
            const float r2 = 1.f / sqrtf(wave_sum(s2) * (1.f / D) + EPS);
            const GAS f32x4* p4 = (const GAS f32x4*)wpre + lane;
#pragma unroll
            for (int j = 0; j < 16; ++j) { const f32x4 g = p4[64 * j];
                v2u o; o.x = pk2(v[j].x * r2 * g.x, v[j].y * r2 * g.y); o.y = pk2(v[j].z * r2 * g.z, v[j].w * r2 * g.w); *(GAS v2u*)(xnb + tiled_off(m, 4 * lane + 256 * j, D)) = o; }
        }
    }
}

struct Args { const float* in[19]; float* out; unsigned char* ws; int ph_lo, ph_hi, li, pad; };
__global__ void __launch_bounds__(NWAVES * 64, 2) skel_fwd(Args args) {
    extern __shared__ __attribute__((aligned(16))) unsigned char lds[];
    Frame F;
    F.lds = (LAS unsigned char*)lds;
    F.MISC = (volatile LAS unsigned*)(F.lds + MISC_OFF);
    F.tid = threadIdx.x; F.lane = F.tid & 63; F.wave = __builtin_amdgcn_readfirstlane(F.tid >> 6);
    F.G = gridDim.x; { const int bx = blockIdx.x; F.vcu = (F.G % 8 == 0) ? (bx % 8) * (F.G / 8) + bx / 8 : bx; }
    unsigned char* ws = args.ws; F.ws = ws;
    F.ctl = (gu32*)(ws + WS_CTL);
#pragma unroll
    for (int i = 0; i < 19; ++i) F.in[i] = args.in[i];
    F.out = args.out;
    for (int u = F.tid; u < (LDS_BYTES - LDSCTL_OFF) / 4; u += NWAVES * 64) ((LAS unsigned*)(F.lds + LDSCTL_OFF))[u] = 0u;
    __syncthreads();
    XcdBarrier bar; bar.bar = (unsigned*)(F.ctl + CW_BAR); bar.x = 0; bar.st = nullptr;
    if (ONE_LAUNCH) bar = xcd_barrier_post((unsigned*)(F.ctl + CW_BAR), F.MISC + 8);
#define GRID_BAR() do { if (ONE_LAUNCH) xcd_barrier(bar); } while (0)
#define SELF_ACQ() do { asm volatile("s_waitcnt vmcnt(0)" ::: "memory"); __syncthreads(); __builtin_amdgcn_fence(__ATOMIC_ACQUIRE, "agent"); asm volatile("s_waitcnt vmcnt(0)" ::: "memory"); __syncthreads(); } while (0)
    const int lo = args.ph_lo, hi = args.ph_hi;
#define IN(k) (lo <= (k) && (k) < hi)
#define BOTH(k) (IN(k) && IN((k) + 1))
    bf16* XN = (bf16*)(ws + WS_XN); bf16* P2 = (bf16*)(ws + WS_P2); float* SS = (float*)(ws + WS_SS);
    const int c = (int)blockIdx.x;

    if (IN(0)) { p0_prologue(F); if (BOTH(0)) GRID_BAR(); }
    if (IN(1)) {
        pg8::Gemm g{XN, (const bf16*)(ws + WS_WIN), M, NIN, D, D / 64, D}; pg8::StaticOrder S; S.init(M, NIN, F.G, c);
        pg8::Epi<6> E{P2, NP2, nullptr, 0, nullptr, 0, nullptr, (bf16*)(ws + WS_PROJ)};
        pg8::gemm_phase<pg8::Epi<6>, pg8::StaticOrder, PG8_ALIGN, PG8_SP2>(F.lds + RING_OFF, g, S, E);
        if (BOTH(1)) GRID_BAR();
    }
    if (IN(2)) {
        for (int u = c; u < 64 * scn::NSEG; u += F.G) scn::scan_unit(F, u);
        for (int u = c; u < 1024; u += F.G) att::attn_unit(F, u);
        if (BOTH(2)) GRID_BAR();
    }
    if (IN(3)) {
        for (int u = c; u < 64 * scn::NSEG; u += F.G) if (u & (scn::NSEG - 1)) scn::fixup_unit(F, u);
        if (BOTH(3)) GRID_BAR();
    }
    if (IN(4)) { ohnorm_phase(F); if (BOTH(4)) GRID_BAR(); }
    if (IN(5)) {
        pg8::Gemm g{XN, (const bf16*)(ws + WS_WHP), M, D, HW, D / 64, HW}; pg8::StaticOrder S; S.init(M, D, F.G, c);
        pg8::Epi<1> E{P2 + C2_GA, NP2, P2 + C2_GA, NP2, nullptr, 0, nullptr};
        pg8::gemm_phase<pg8::Epi<1>, pg8::StaticOrder, PG8_ALIGN, PG8_SP2>(F.lds + RING_OFF, g, S, E);
        if (BOTH(5)) SELF_ACQ();
    }
    if (IN(6)) {
        pg8::Gemm g{XN + (size_t)(HW / 64) * (256 * 64), (const bf16*)(ws + WS_WAP), M, D, HW, D / 64, HW}; pg8::StaticOrder S; S.init(M, D, F.G, c);
        pg8::Epi<2> E{(bf16*)(ws + WS_Y), D, P2 + C2_GA, NP2, P2 + C2_GB, NP2, nullptr, nullptr, D / 64};
        pg8::gemm_phase<pg8::Epi<2>, pg8::StaticOrder, PG8_ALIGN, PG8_SP2>(F.lds + RING_OFF, g, S, E);
        if (BOTH(6)) GRID_BAR();
    }
    if (IN(7)) {
        pg8::Gemm g{(const bf16*)(ws + WS_Y), (const bf16*)(ws + WS_WOUT), M, D, D, D / 64, D}; pg8::StaticOrder S; S.init(M, D, F.G, c);
        pg8::Epi<3> E{(bf16*)(ws + WS_MIX), D, nullptr, 0, nullptr, 0, SS};
        pg8::gemm_phase<pg8::Epi<3>, pg8::StaticOrder, PG8_ALIGN, PG8_SP2>(F.lds + RING_OFF, g, S, E);
        if (BOTH(7)) GRID_BAR();
    }
    if (IN(8)) { resid_phase<0>(F, (const bf16*)(ws + WS_MIX), F.in[0], XN, (bf16*)F.out, F.in[3], F.in[12]); if (BOTH(8)) GRID_BAR(); }
    if (IN(9)) {
        pg8::Gemm g{XN, (const bf16*)(ws + WS_WUP), M, DFF, D, D / 64, D}; pg8::StaticOrder S; S.init(M, DFF, F.G, c);
        pg8::Epi<4> E{(bf16*)(ws + WS_U), DFF, nullptr, 0, nullptr, 0, nullptr, nullptr, DFF / 64};
        pg8::gemm_phase<pg8::Epi<4>, pg8::StaticOrder, PG8_ALIGN, PG8_SP2>(F.lds + RING_OFF, g, S, E);
        if (BOTH(9)) GRID_BAR();
    }
    if (IN(10)) {
        pg8::Gemm g{(const bf16*)(ws + WS_U), (const bf16*)(ws + WS_WDN), M, D, DFF, DFF / 64, DFF}; pg8::StaticOrder S; S.init(M, D, F.G, c);
        pg8::Epi<3> E{(bf16*)(ws + WS_MIX), D, nullptr, 0, nullptr, 0, SS};
        pg8::gemm_phase<pg8::Epi<3>, pg8::StaticOrder, PG8_ALIGN, PG8_SP2>(F.lds + RING_OFF, g, S, E);
        if (BOTH(10)) GRID_BAR();
    }
    if (IN(11)) { resid_phase<1>(F, (const bf16*)(ws + WS_MIX), F.in[0], (const bf16*)F.out, (bf16*)F.out, F.in[13], nullptr); if (BOTH(11)) GRID_BAR(); }
    if (IN(12)) {
        pg8::Gemm g{(const bf16*)(ws + WS_PBF), (const bf16*)(ws + WS_WPLE), M, D, PLE, PLE / 64, PLE}; pg8::StaticOrder S; S.init(M, D, F.G, c);
        pg8::Epi<0> E{(bf16*)(ws + WS_E), D, nullptr, 0, nullptr, 0, nullptr};
        pg8::gemm_phase<pg8::Epi<0>, pg8::StaticOrder, PG8_ALIGN, PG8_SP2>(F.lds + RING_OFF, g, S, E);
        if (BOTH(12)) SELF_ACQ();
    }
    if (IN(13)) {
        pg8::Gemm g{XN, (const bf16*)(ws + WS_WPG), M, D, D, D / 64, D}; pg8::StaticOrder S; S.init(M, D, F.G, c);
        pg8::Epi<5> E{(bf16*)(ws + WS_V), D, (const bf16*)(ws + WS_E), D, nullptr, 0, SS};
        pg8::gemm_phase<pg8::Epi<5>, pg8::StaticOrder, PG8_ALIGN, PG8_SP2>(F.lds + RING_OFF, g, S, E);
        if (BOTH(13)) GRID_BAR();
    }
    if (IN(14)) { resid_phase<2>(F, (const bf16*)(ws + WS_V), F.in[0], XN, (bf16*)F.out, F.in[18], nullptr); }
#undef IN
#undef BOTH
#undef GRID_BAR
}

extern "C" void kernel_launch(void* const* d_in, const int* in_sizes, int n_in, void* d_out, int out_size, void* d_ws, size_t ws_size, hipStream_t stream) {
    static int grid = 0;
    if (grid == 0) {
        if (n_in != 19 || in_sizes[0] != M * D || out_size != M * D || ws_size < WS_END) { fprintf(stderr, "kernel_launch: unexpected shapes: n_in %d in0 %d out %d ws %zu (need %zu)\n", n_in, n_in > 0 ? in_sizes[0] : -1, out_size, ws_size, (size_t)WS_END); grid = -1; return; }
        int dev = 0, cus = 0, per_cu = 0;
        if (hipGetDevice(&dev) != hipSuccess || hipDeviceGetAttribute(&cus, hipDeviceAttributeMultiprocessorCount, dev) != hipSuccess) { fprintf(stderr, "kernel_launch: device query failed\n"); grid = -1; return; }
        if (hipFuncSetAttribute((const void*)skel_fwd, hipFuncAttributeMaxDynamicSharedMemorySize, LDS_BYTES) != hipSuccess) { fprintf(stderr, "kernel_launch: hipFuncSetAttribute failed\n"); grid = -1; return; }
        if (hipOccupancyMaxActiveBlocksPerMultiprocessor(&per_cu, (const void*)skel_fwd, NWAVES * 64, LDS_BYTES) != hipSuccess || per_cu < 1)
            fprintf(stderr, "kernel_launch: note: occupancy query reports %d workgroups per CU\n", per_cu);
        (void)hipGetLastError();
        grid = cus;
    }
    if (grid < 0) return;
    if (hipMemsetAsync((char*)d_ws + WS_CTL, 0, CTL_ZERO_BYTES, stream) != hipSuccess) { fprintf(stderr, "kernel_launch: memset failed\n"); return; }
    Args a{};
    for (int i = 0; i < 19; ++i) a.in[i] = (const float*)d_in[i];
    a.out = (float*)d_out; a.ws = (unsigned char*)d_ws;
    const int nl = ONE_LAUNCH ? 1 : NPH;
    for (int li = 0; li < nl; ++li) {
        a.ph_lo = ONE_LAUNCH ? 0 : li; a.ph_hi = ONE_LAUNCH ? NPH : li + 1; a.li = li; a.pad = 0;
        hipLaunchKernelGGL(skel_fwd, dim3(grid), dim3(NWAVES * 64), LDS_BYTES, stream, a);
        const hipError_t le = hipPeekAtLastError();
        if (le != hipSuccess) { fprintf(stderr, "kernel_launch: launch %d failed: %s\n", li, hipGetErrorName(le)); break; }
    }
}
```

```cpp
#include <hip/hip_runtime.h>
#include <cstdio>
#include <cstdint>

namespace pg8 {
#define PG8_LAS __attribute__((address_space(3)))
typedef unsigned short bf16_t;
typedef short bf16x8 __attribute__((ext_vector_type(8)));
typedef float f32x4 __attribute__((ext_vector_type(4)));
typedef unsigned u32x4 __attribute__((ext_vector_type(4)));
constexpr int BM = 256, BK = 64, HALF = 128, HTB = HALF * BK * 2, STAGE_BYTES = 8 * HTB, NXCD = 8, WGM = 8;

__host__ __device__ __forceinline__ int lds_byte(int r, int c) { const int st = (r >> 4) * 2 + (c >> 5), rr = r & 15, cc = c & 31, ob = rr * 64 + cc * 2; return st * 1024 + (ob ^ (((ob >> 9) & 1) << 5)); }
__host__ __device__ __forceinline__ void stage_rc(int b, int& R, int& C) { const int st = b / 1024, sb = b % 1024, swz = sb ^ (((sb >> 9) & 1) << 5); R = (st >> 1) * 16 + swz / 64; C = (st & 1) * 32 + (swz % 64) / 2; }
__host__ __device__ __forceinline__ int perm32(int rho) { const int n = rho >> 4, i = rho & 15; return 8 * (i >> 2) + 4 * n + (i & 3); }

struct Unit { int pm, pn; };
struct Gemm { const bf16_t* A; const bf16_t* Bt; int M, N, K, lda, ldb; };

struct StaticOrder {
    int nM, nN, nwg, G, c;
    __host__ __device__ void init(int M, int N, int G_, int c_) { nM = M / BM; nN = N / BM; nwg = nM * nN; G = G_; c = c_; }
    __host__ __device__ bool next(int i, Unit& u) const {
        const long L = (long)i * G + c; if (L >= nwg) return false;
        int wgid = (int)L; { const int q = nwg / NXCD, r = nwg % NXCD, xcd = wgid % NXCD, off = wgid / NXCD; wgid = (xcd < r ? xcd * (q + 1) : r * (q + 1) + (xcd - r) * q) + off; }
        const int nig = WGM * nN, gid = wgid / nig, fm = gid * WGM, gsz = (nM - fm) < WGM ? (nM - fm) : WGM;
        u.pm = fm + ((wgid % nig) % gsz); u.pn = (wgid % nig) / gsz; return true;
    }
    __device__ __forceinline__ void a_ready(const Unit&) const {}
    __device__ __forceinline__ void done(const Unit&) const {}
};

typedef float f32x2_t __attribute__((ext_vector_type(2)));
typedef __bf16 bf16x2_t __attribute__((ext_vector_type(2)));
__device__ __forceinline__ unsigned cvt_pk_bf16(float lo, float hi) { const f32x2_t v = {lo, hi}; return __builtin_bit_cast(unsigned, __builtin_convertvector(v, bf16x2_t)); }
__device__ __forceinline__ float sigm(float x) { return __builtin_amdgcn_rcpf(1.0f + __expf(-x)); }
__device__ __forceinline__ float bflo(unsigned w) { return __uint_as_float(w << 16); }
__device__ __forceinline__ float bfhi(unsigned w) { return __uint_as_float(w & 0xffff0000u); }

template <int MODE> struct Epi {
    static constexpr bool PERM = true, AFTER_DRAIN = false;
    bf16_t* O; int ldc; const bf16_t* G1; int ldg1; const bf16_t* G2; int ldg2; float* SS;
    bf16_t* CB;
    int tkt;
    __device__ __forceinline__ void operator()(const f32x4 (&acc)[2][2][4][2], const Unit& u, int wr, int wc, int fr, int fq) const {
        if constexpr (MODE == 6) {
            const int pn = u.pn;
            const int am = (pn < 8) ? 1 : (pn < 24) ? 2 : (pn >= 32 && pn < 40) ? 3 : 0;
            bf16_t* ob; size_t rs, bs; int rsub;
            const int bb = (u.pm * BM) / 8192;
            if (pn < 32 || (pn >= 40 && pn < 52)) {
                size_t toff; int h0, nh;
                if (pn < 32) { toff = (size_t)(pn >> 3) << 25; h0 = (pn & 7) * 2; nh = 16; }
                else if (pn < 48) { toff = (size_t)128 << 20; h0 = (pn - 40) * 2; nh = 16; }
                else if (pn < 50) { toff = (size_t)160 << 20; h0 = (pn - 48) * 2; nh = 4; }
                else { toff = (size_t)168 << 20; h0 = (pn - 50) * 2; nh = 4; }
                ob = CB + toff + (size_t)(bb * nh + h0) * 8192 * 128 + wc * 32 + 8 * fq; rs = 128; bs = (size_t)8192 * 128; rsub = bb * 8192;
            } else {
                const int c2 = (pn < 40) ? (pn - 32) * 256 : (pn - 52) * 256 + 2048;
                ob = O + c2 + wc * 32 + 8 * fq; rs = (size_t)ldc; bs = HALF; rsub = 0;
            }
            if (am == 0) run<0>(acc, u, wr, wc, fr, fq, 0, ob, rs, bs, rsub); else if (am == 1) run<7>(acc, u, wr, wc, fr, fq, 1, ob, rs, bs, rsub); else if (am == 2) run<8>(acc, u, wr, wc, fr, fq, 2, ob, rs, bs, rsub); else run<9>(acc, u, wr, wc, fr, fq, 3, ob, rs, bs, rsub);
        } else if (tkt > 0) run<MODE>(acc, u, wr, wc, fr, fq, 0, O + (size_t)(u.pm * tkt + u.pn * 4 + (wc >> 1)) * (BM * BK) + 32 * (wc & 1) + 8 * fq, (size_t)BK, (size_t)2 * BM * BK, u.pm * BM);
        else run<MODE>(acc, u, wr, wc, fr, fq, 0, O + u.pn * BM + wc * 32 + 8 * fq, (size_t)ldc, (size_t)HALF, 0);
    }
    template <int MD> __device__ __forceinline__ void run(const f32x4 (&acc)[2][2][4][2], const Unit& u, int wr, int wc, int fr, int fq, int am, bf16_t* ob, size_t rs, size_t bs, int rsub) const {
        const int row0 = u.pm * BM + wr * 64 + fr, col0 = u.pn * BM + wc * 32 + 8 * fq;
#pragma unroll
        for (int ai = 0; ai < 2; ++ai) {
            u32x4 g1v[4][2], g2v[4][2];
            if (MD == 1 || MD == 5) {
#pragma unroll
                for (int m = 0; m < 4; ++m)
#pragma unroll
                    for (int bj = 0; bj < 2; ++bj) g1v[m][bj] = *(const u32x4*)(G1 + (size_t)(row0 + ai * HALF + m * 16) * ldg1 + col0 + bj * HALF);
                asm volatile("" ::: "memory");
            }
#pragma unroll
            for (int m = 0; m < 4; ++m) {
                const int row = row0 + ai * HALF + m * 16; float ssq = 0.f;
                if (MD == 2) {
#pragma unroll
                    for (int bj = 0; bj < 2; ++bj) { g1v[m][bj] = *(const u32x4*)(G1 + (size_t)row * ldg1 + col0 + bj * HALF); g2v[m][bj] = *(const u32x4*)(G2 + (size_t)row * ldg2 + col0 + bj * HALF); }
                }
#pragma unroll
                for (int bj = 0; bj < 2; ++bj) {
                    float v[8];
#pragma unroll
                    for (int j = 0; j < 4; ++j) { v[j] = acc[ai][bj][m][0][j]; v[4 + j] = acc[ai][bj][m][1][j]; }
                    if (MD == 1 || MD == 2 || MD == 5) {
                        const u32x4 a = g1v[m][bj];
                        float g[8] = {bflo(a.x), bfhi(a.x), bflo(a.y), bfhi(a.y), bflo(a.z), bfhi(a.z), bflo(a.w), bfhi(a.w)};
                        if (MD == 1) {
#pragma unroll
                            for (int j = 0; j < 8; ++j) v[j] = sigm(g[j]) * v[j];
                        } else if (MD == 5) {
#pragma unroll
                            for (int j = 0; j < 8; ++j) v[j] = g[j] * sigm(v[j]);
                        } else {
                            const u32x4 b = g2v[m][bj];
                            float h[8] = {bflo(b.x), bfhi(b.x), bflo(b.y), bfhi(b.y), bflo(b.z), bfhi(b.z), bflo(b.w), bfhi(b.w)};
#pragma unroll
                            for (int j = 0; j < 8; ++j) v[j] = g[j] + sigm(h[j]) * v[j];
                        }
                    }
                    if (MD == 7) {
#pragma unroll
                        for (int j = 0; j < 8; ++j) v[j] = v[j] * sigm(v[j]) * 0.08838834764831845f;
                    }
                    if (MD == 8) {
#pragma unroll
                        for (int j = 0; j < 8; ++j) v[j] = sigm(-v[j]);
                    }
                    if (MD == 9) {
#pragma unroll
                        for (int j = 0; j < 8; ++j) v[j] = v[j] * sigm(v[j]);
                    }
                    if (MD == 4) {
#pragma unroll
                        for (int j = 0; j < 8; ++j) { const float r = fmaxf(v[j], 0.f); v[j] = r * r; }
                    }
                    if (MD == 3 || MD == 5) {
#pragma unroll
                        for (int j = 0; j < 8; ++j) ssq += v[j] * v[j];
                    }
                    u32x4 w; w.x = cvt_pk_bf16(v[0], v[1]); w.y = cvt_pk_bf16(v[2], v[3]); w.z = cvt_pk_bf16(v[4], v[5]); w.w = cvt_pk_bf16(v[6], v[7]);
                    *(u32x4*)(ob + (size_t)(row - rsub) * rs + bj * bs) = w;
                }
                if (MD == 3 || MD == 5) {
                    ssq += __shfl_xor(ssq, 16); ssq += __shfl_xor(ssq, 32);
                    if (fq == 0) SS[(size_t)row * 64 + u.pn * 4 + wc] = ssq;
                }
            }
        }
    }
};

template <class Epi, class Sched, bool ALIGN_EPI = false, bool SP2 = false>
__device__ __forceinline__ void gemm_phase(PG8_LAS unsigned char* lds, const Gemm g, const Sched& S, const Epi& E) {
    const int tid = threadIdx.x, wid = __builtin_amdgcn_readfirstlane(tid >> 6), lane = tid & 63, wr = wid >> 2, wc = wid & 3, fr = lane & 15, fq = lane >> 4;
    const int K = g.K, nt = K / BK;
    unsigned voffA[2], voffB[2];
#pragma unroll
    for (int i = 0; i < 2; ++i) { int R, C; stage_rc(tid * 16 + i * 8192, R, C); const int Rb = Epi::PERM ? ((R & ~31) + perm32(R & 31)) : R;
        voffA[i] = (unsigned)(R * BK + C) * 2u; voffB[i] = (unsigned)(Rb * BK + C) * 2u; }
    const size_t kstep = (size_t)BM * BK * 2, kstepB = kstep;
    const size_t hsA = (size_t)HALF * BK * 2, hsB = hsA;
    const size_t tsA = (size_t)g.lda * kstep, tsB = (size_t)nt * kstepB;
    const unsigned ldsw = (unsigned)wid * 1024u;
    const int aoff = lds_byte(wr * 64 + fr, fq * 8), boff = lds_byte(wc * 32 + fr, fq * 8);
#define PG8_SA(b, h) (((b) * 2 + (h)) * HTB)
#define PG8_SB(b, h) ((4 + (b) * 2 + (h)) * HTB)
#define PG8_STAGE(bufoff, gbase, voff) do { _Pragma("unroll") for (int _i = 0; _i < 2; ++_i) \
        __builtin_amdgcn_global_load_lds((const unsigned*)((const char*)(gbase) + (voff)[_i]), (PG8_LAS unsigned*)(lds + (bufoff) + ldsw + _i * 8192), 16, 0, 0); } while (0)
#define PG8_LDA(dst, b, h) do { _Pragma("unroll") for (int m = 0; m < 4; ++m) _Pragma("unroll") for (int k = 0; k < 2; ++k) dst[m][k] = *(const PG8_LAS bf16x8*)(lds + PG8_SA(b, h) + aoff + m * 2048 + k * 1024); } while (0)
#define PG8_LDB(dst, b, h) do { _Pragma("unroll") for (int n = 0; n < 2; ++n) _Pragma("unroll") for (int k = 0; k < 2; ++k) dst[n][k] = *(const PG8_LAS bf16x8*)(lds + PG8_SB(b, h) + boff + n * 2048 + k * 1024); } while (0)
#define PG8_MMA(ai, bj, At, Bt) do { __builtin_amdgcn_s_setprio(1); _Pragma("unroll") for (int m = 0; m < 4; ++m) _Pragma("unroll") for (int n = 0; n < 2; ++n) _Pragma("unroll") for (int k = 0; k < 2; ++k) \
        acc[ai][bj][m][n] = __builtin_amdgcn_mfma_f32_16x16x32_bf16(Bt[n][k], At[m][k], acc[ai][bj][m][n], 0, 0, 0); __builtin_amdgcn_s_setprio(0); } while (0)
#define PG8_WAIT_V(n) asm volatile("s_waitcnt vmcnt(" #n ")" ::: "memory")
#define PG8_WAIT_L(n) asm volatile("s_waitcnt lgkmcnt(" #n ")" ::: "memory")
#define PG8_BAR __builtin_amdgcn_s_barrier()
#define PG8_SCHED __builtin_amdgcn_sched_barrier(0)
    Unit cur, nxt; int ui = 0;
    if (!S.next(0, cur)) return;
    f32x4 acc[2][2][4][2];
#pragma unroll
    for (int a = 0; a < 2; ++a)
#pragma unroll
        for (int b = 0; b < 2; ++b)
#pragma unroll
            for (int m = 0; m < 4; ++m)
#pragma unroll
                for (int n = 0; n < 2; ++n) acc[a][b][m][n] = (f32x4){0.f, 0.f, 0.f, 0.f};
    bf16x8 At[4][2], B0[2][2], B1[2][2];
    const char* cA = (const char*)g.A + (size_t)cur.pm * tsA; const char* cB = (const char*)g.Bt + (size_t)cur.pn * tsB;
    S.a_ready(cur);
    if constexpr (SP2) {
        PG8_STAGE(PG8_SB(0, 0), cB, voffB); PG8_STAGE(PG8_SB(0, 1), cB + hsB, voffB); PG8_STAGE(PG8_SA(0, 0), cA, voffA); PG8_STAGE(PG8_SA(0, 1), cA + hsA, voffA);
        if (wr == 1) PG8_BAR;
        PG8_WAIT_V(2); PG8_BAR;
        PG8_STAGE(PG8_SB(1, 0), cB + kstepB, voffB); PG8_STAGE(PG8_SA(1, 0), cA + kstep, voffA); PG8_STAGE(PG8_SB(1, 1), cB + hsB + kstepB, voffB);
        PG8_WAIT_V(6); PG8_BAR;
    } else {
        PG8_STAGE(PG8_SB(0, 0), cB, voffB); PG8_STAGE(PG8_SA(0, 0), cA, voffA); PG8_STAGE(PG8_SB(0, 1), cB + hsB, voffB); PG8_STAGE(PG8_SA(0, 1), cA + hsA, voffA);
        if (wr == 1) PG8_BAR;
        PG8_WAIT_V(4); PG8_BAR;
        PG8_STAGE(PG8_SB(1, 0), cB + kstepB, voffB); PG8_STAGE(PG8_SA(1, 0), cA + kstep, voffA); PG8_STAGE(PG8_SB(1, 1), cB + hsB + kstepB, voffB);
        PG8_WAIT_V(6); PG8_BAR;
    }
    for (;;) {
        const bool has_next = S.next(ui + 1, nxt);
        const char* nA = has_next ? (const char*)g.A + (size_t)nxt.pm * tsA : cA; const char* nB = has_next ? (const char*)g.Bt + (size_t)nxt.pn * tsB : cB;
#pragma nounroll
        for (int t = 0; t < nt; t += 2) {
            const bool last = (t == nt - 2);
            const char* a1 = cA + (size_t)(t + 1) * kstep;
            const char* a2 = last ? nA : cA + (size_t)(t + 2) * kstep; const char* b2 = last ? nB : cB + (size_t)(t + 2) * kstepB;
            const char* a3 = a2 + kstep; const char* b3 = b2 + kstepB;
            if (last && has_next) S.a_ready(nxt);
            if constexpr (SP2) {
            PG8_LDB(B0, 0, 0); PG8_LDB(B1, 0, 1); PG8_SCHED; PG8_LDA(At, 0, 0); PG8_STAGE(PG8_SA(1, 1), a1 + hsA, voffA);
            PG8_WAIT_V(8); PG8_WAIT_L(0); PG8_BAR; PG8_MMA(0, 0, At, B0); PG8_MMA(0, 1, At, B1); PG8_BAR; PG8_SCHED;
            PG8_LDA(At, 0, 1); PG8_STAGE(PG8_SB(0, 0), b2, voffB); PG8_STAGE(PG8_SB(0, 1), b2 + hsB, voffB); PG8_STAGE(PG8_SA(0, 0), a2, voffA);
            PG8_WAIT_V(8); PG8_WAIT_L(0); PG8_BAR; PG8_MMA(1, 0, At, B0); PG8_MMA(1, 1, At, B1); PG8_BAR; PG8_SCHED;
            PG8_LDB(B0, 1, 0); PG8_LDB(B1, 1, 1); PG8_SCHED; PG8_LDA(At, 1, 0); PG8_STAGE(PG8_SA(0, 1), a2 + hsA, voffA);
            PG8_WAIT_V(8); PG8_WAIT_L(0); PG8_BAR; PG8_MMA(0, 0, At, B0); PG8_MMA(0, 1, At, B1); PG8_BAR; PG8_SCHED;
            PG8_LDA(At, 1, 1); PG8_STAGE(PG8_SB(1, 0), b3, voffB); PG8_STAGE(PG8_SB(1, 1), b3 + hsB, voffB); PG8_STAGE(PG8_SA(1, 0), a3, voffA);
            PG8_WAIT_V(8); PG8_WAIT_L(0); PG8_BAR; PG8_MMA(1, 0, At, B0); PG8_MMA(1, 1, At, B1); PG8_BAR; PG8_SCHED;
            } else {
            PG8_LDB(B0, 0, 0); PG8_SCHED; PG8_LDA(At, 0, 0); PG8_STAGE(PG8_SA(1, 1), a1 + hsA, voffA);
            PG8_WAIT_L(8); PG8_BAR; PG8_WAIT_L(0); PG8_MMA(0, 0, At, B0); PG8_BAR; PG8_SCHED;
            PG8_LDB(B1, 0, 1); PG8_STAGE(PG8_SB(0, 0), b2, voffB);
            PG8_BAR; PG8_WAIT_L(0); PG8_MMA(0, 1, At, B1); PG8_BAR;
            PG8_LDA(At, 0, 1); PG8_STAGE(PG8_SA(0, 0), a2, voffA);
            PG8_BAR; PG8_WAIT_L(0); PG8_MMA(1, 0, At, B0); PG8_BAR; PG8_SCHED;
            PG8_STAGE(PG8_SB(0, 1), b2 + hsB, voffB);
            PG8_WAIT_V(6); PG8_BAR; PG8_MMA(1, 1, At, B1); PG8_BAR;
            PG8_LDB(B0, 1, 0); PG8_SCHED; PG8_LDA(At, 1, 0); PG8_STAGE(PG8_SA(0, 1), a2 + hsA, voffA);
            PG8_WAIT_L(8); PG8_BAR; PG8_WAIT_L(0); PG8_MMA(0, 0, At, B0); PG8_BAR; PG8_SCHED;
            PG8_LDB(B1, 1, 1); PG8_STAGE(PG8_SB(1, 0), b3, voffB);
            PG8_BAR; PG8_WAIT_L(0); PG8_MMA(0, 1, At, B1); PG8_BAR;
            PG8_LDA(At, 1, 1); PG8_STAGE(PG8_SA(1, 0), a3, voffA);
            PG8_BAR; PG8_WAIT_L(0); PG8_MMA(1, 0, At, B0); PG8_BAR; PG8_SCHED;
            PG8_STAGE(PG8_SB(1, 1), b3 + hsB, voffB);
            PG8_WAIT_V(6); PG8_BAR; PG8_MMA(1, 1, At, B1); PG8_BAR;
            }
        }
        if constexpr (ALIGN_EPI) { if (wr == 0) PG8_BAR; }
        if constexpr (!Epi::AFTER_DRAIN) { E(acc, cur, wr, wc, fr, fq); S.done(cur); }
        if (!has_next) break;
#pragma unroll
        for (int a = 0; a < 2; ++a)
#pragma unroll
            for (int b = 0; b < 2; ++b)
#pragma unroll
                for (int m = 0; m < 4; ++m)
#pragma unroll
                    for (int n = 0; n < 2; ++n) acc[a][b][m][n] = (f32x4){0.f, 0.f, 0.f, 0.f};
        cur = nxt; cA = nA; cB = nB; ++ui;
        if constexpr (ALIGN_EPI) { if (wr == 1) PG8_BAR; }
    }
    PG8_WAIT_V(0);
    if constexpr (!ALIGN_EPI) { if (wr == 0) PG8_BAR; }
    PG8_BAR;
#undef PG8_SA
#undef PG8_SB
#undef PG8_STAGE
#undef PG8_LDA
#undef PG8_LDB
#undef PG8_MMA
#undef PG8_WAIT_V
#undef PG8_WAIT_L
#undef PG8_BAR
#undef PG8_SCHED
}
}

#ifndef PG8_SP2
#define PG8_SP2 true
#endif
#ifndef PG8_ALIGN
#define PG8_ALIGN true
#endif

constexpr int NWAVES = 8;
#ifndef MK_N_LAUNCHES
#define MK_N_LAUNCHES 1
#endif
constexpr int NPH = 15;
constexpr bool ONE_LAUNCH = (MK_N_LAUNCHES == 1);

constexpr int BATCH = 2, SEQ = 8192, D = 4096, M = BATCH * SEQ;
constexpr int HW = 2048, NH = 16, HD = 128, NKV = 4, DFF = 16384, PLE = 256;
constexpr int NIN = 21504;
constexpr int NP2 = 10240, C2_HG = 0, C2_GA = 2048, C2_GB = 6144;
constexpr float EPS = 1e-6f;

constexpr size_t MiB = 1u << 20;
constexpr size_t WS_CTL = 0, CTL_ZERO_BYTES = 1 * MiB;
constexpr size_t WS_LB = 1 * MiB;
constexpr size_t WS_ROPE = 2 * MiB;
constexpr size_t WS_SS = 6 * MiB;
constexpr size_t WS_PBF = 10 * MiB;
constexpr size_t WS_WIN = 18 * MiB;
constexpr size_t WS_WHP = 186 * MiB, WS_WAP = 202 * MiB, WS_WOUT = 218 * MiB, WS_WUP = 250 * MiB, WS_WDN = 378 * MiB, WS_WPLE = 506 * MiB, WS_WPG = 508 * MiB;
constexpr size_t WS_XN = 540 * MiB;
constexpr size_t WS_PROJ = 668 * MiB;
constexpr size_t WS_SQ = WS_PROJ, WS_SFF = WS_PROJ + 64 * MiB, WS_SFB = WS_PROJ + 128 * MiB, WS_SV = WS_PROJ + 192 * MiB;
constexpr size_t WS_ATQ = WS_PROJ + 256 * MiB, WS_ATK = WS_PROJ + 320 * MiB, WS_ATV = WS_PROJ + 336 * MiB, WS_P2 = WS_PROJ + 352 * MiB;
constexpr size_t WS_END = 1340 * MiB;
constexpr size_t WS_OF = WS_WIN, WS_OB = WS_WIN + 64 * MiB, WS_MIX = WS_WIN;
constexpr size_t WS_Y = WS_PROJ;
constexpr size_t WS_SEND = 146 * MiB, WS_DTOT = 162 * MiB;
constexpr size_t WS_U = WS_PROJ, WS_E = WS_PROJ, WS_V = WS_PROJ + 128 * MiB;
constexpr int CW_TMO = 0, CW_CODE = 1;
constexpr int CW_BAR = 4096;

constexpr int RING_OFF = 0, RING_BYTES = 131072;
constexpr int LDSCTL_OFF = RING_BYTES, MISC_OFF = LDSCTL_OFF + 320;
constexpr int LDS_BYTES = 147456;

#define GAS __attribute__((address_space(1)))
#define LAS __attribute__((address_space(3)))
typedef unsigned short bf16;
typedef unsigned v4u __attribute__((ext_vector_type(4)));
typedef unsigned v2u __attribute__((ext_vector_type(2)));
typedef float f32x4 __attribute__((ext_vector_type(4)));
typedef float f32x2 __attribute__((ext_vector_type(2)));
typedef GAS unsigned gu32;
#define RLX_AGENT __ATOMIC_RELAXED, __HIP_MEMORY_SCOPE_AGENT
#define LDS_WAIT() asm volatile("s_waitcnt lgkmcnt(0)" ::: "memory")
#define VM_WAIT() asm volatile("s_waitcnt vmcnt(0)" ::: "memory")
__device__ __forceinline__ size_t tiled_off(int r, int k, int Kt) { return ((size_t)((r >> 8) * (Kt >> 6) + (k >> 6)) * 256 + (r & 255)) * 64 + (k & 63); }
__device__ __forceinline__ unsigned f2bf(float f) { unsigned u = __builtin_bit_cast(unsigned, f); return (u + 0x7fffu + ((u >> 16) & 1u)) >> 16; }
__device__ __forceinline__ unsigned pk2(float lo, float hi) { return f2bf(lo) | (f2bf(hi) << 16); }
__device__ __forceinline__ float bf2f(bf16 b) { return __uint_as_float((unsigned)b << 16); }
__device__ __forceinline__ float blo(unsigned w) { return __uint_as_float(w << 16); }
__device__ __forceinline__ float bhi(unsigned w) { return __uint_as_float(w & 0xffff0000u); }

#define XB_TMO      128
#define XB_XCNT(j)  (256  + 64 * (j))
#define XB_XSUB(j)  (1280 + 64 * (j))
#define XB_XGEN(j)  (2304 + 64 * (j))
#define XB_TOP      3328
#define XB_TOPGEN   3392
#define XCD_BAR_WORDS 3456
#define XB_SPIN_CAP (1u << 18)

__device__ __forceinline__ unsigned xb_ld(unsigned* p)              { return __hip_atomic_load(p, __ATOMIC_RELAXED, __HIP_MEMORY_SCOPE_AGENT); }
__device__ __forceinline__ unsigned xb_add(unsigned* p, unsigned v) { return __hip_atomic_fetch_add(p, v, __ATOMIC_RELAXED, __HIP_MEMORY_SCOPE_AGENT); }
__device__ __forceinline__ unsigned xb_xcc_id() { return (unsigned)__builtin_amdgcn_s_getreg((3 << 11) | 20) & 0xFu; }
#define XB_SPIN(cond, bar) do { unsigned _sp = 0; while (cond) { __builtin_amdgcn_s_sleep(1); \
    if ((++_sp & 255u) == 0u) { if (xb_ld(&(bar)[XB_TMO])) break; if (_sp > XB_SPIN_CAP) { atomicAdd(&(bar)[XB_TMO], 1u); break; } } } } while (0)

struct XcdBarrier { unsigned* bar; unsigned x; volatile LAS unsigned* st; };

__device__ __forceinline__ XcdBarrier xcd_barrier_post(unsigned* bar, volatile LAS unsigned* st) {
    XcdBarrier b; b.bar = bar; b.x = xb_xcc_id(); b.st = st;
    if (threadIdx.x == 0) (void)xb_add(&bar[XB_XCNT(b.x)], 1u);
    return b;
}
__device__ __forceinline__ void xcd_barrier_complete(unsigned* bar, unsigned x, unsigned& nloc, unsigned& nx) {
    const unsigned G = gridDim.x * gridDim.y * gridDim.z;
    unsigned sum, cnt, mine, sp = 0u;
    for (;;) {
        sum = 0u; cnt = 0u; mine = 0u;
#pragma unroll
        for (unsigned j = 0; j < 16; ++j) { const unsigned c = xb_ld(&bar[XB_XCNT(j)]); sum += c; cnt += (c > 0u) ? 1u : 0u; mine = (j == x) ? c : mine; }
        if (sum == G) break;
        __builtin_amdgcn_s_sleep(1);
        if ((++sp & 255u) == 0u) { if (xb_ld(&bar[XB_TMO])) break; if (sp > XB_SPIN_CAP) { atomicAdd(&bar[XB_TMO], 1u); break; } }
    }
    nloc = mine > 0u ? mine : 1u; nx = cnt > 0u ? cnt : 1u;
}
__device__ __forceinline__ void xcd_barrier(const XcdBarrier& b) {
    asm volatile("s_waitcnt vmcnt(0)" ::: "memory");
    __syncthreads();
    if (threadIdx.x == 0) {
        unsigned* bar = b.bar;
        __builtin_amdgcn_s_waitcnt(0);
        unsigned nloc = b.st[0], nx = b.st[1];
        if (nloc == 0u) { xcd_barrier_complete(bar, b.x, nloc, nx); b.st[0] = nloc; b.st[1] = nx; }
        const unsigned old = xb_add(&bar[XB_XSUB(b.x)], 1u);
        const unsigned gen = old / nloc;
        if (old + 1u == (gen + 1u) * nloc) {
            __builtin_amdgcn_fence(__ATOMIC_RELEASE, "agent");
            asm volatile("s_waitcnt vmcnt(0)" ::: "memory");
            const unsigned og = xb_add(&bar[XB_TOP], 1u);
            const unsigned tg = og / nx;
            if (og + 1u == (tg + 1u) * nx) xb_add(&bar[XB_TOPGEN], 1u);
            else XB_SPIN(xb_ld(&bar[XB_TOPGEN]) == tg, bar);
            __builtin_amdgcn_fence(__ATOMIC_ACQUIRE, "agent");
            xb_add(&bar[XB_XGEN(b.x)], 1u);
            asm volatile("s_waitcnt vmcnt(0)" ::: "memory");
        } else {
            XB_SPIN(xb_ld(&bar[XB_XGEN(b.x)]) == gen, bar);
            __builtin_amdgcn_fence(__ATOMIC_ACQUIRE, "agent");
            asm volatile("s_waitcnt vmcnt(0)" ::: "memory");
        }
    }
    __syncthreads();
}

struct Frame {
    LAS unsigned char* lds;
    volatile LAS unsigned* MISC;
    gu32* ctl;
    int tid, lane, wave;
    int vcu, G;
    const float* in[19];
    float* out;
    unsigned char* ws;
};
__device__ __forceinline__ float wave_sum(float v) {
#pragma unroll
    for (int o = 1; o < 64; o <<= 1) v += __shfl_xor(v, o);
    return v;
}
__device__ __forceinline__ float wave_max(float v) {
#pragma unroll
    for (int o = 1; o < 64; o <<= 1) v = fmaxf(v, __shfl_xor(v, o));
    return v;
}

__device__ const double INV_FREQ[64] = {
1.0, 0.8659643233600653, 0.7498942093324559, 0.6493816315762113, 0.5623413251903491, 0.4869675251658631, 0.4216965034285822, 0.3651741272548377, 0.31622776601683794, 0.27384196342643613, 0.23713737056616552, 0.2053525026457146, 0.1778279410038923, 0.1539926526059492, 0.1333521432163324, 0.11547819846894582, 0.1, 0.08659643233600653, 0.07498942093324558, 0.06493816315762113, 0.05623413251903491, 0.04869675251658631, 0.042169650342858224, 0.03651741272548377, 0.03162277660168379, 0.027384196342643614, 0.023713737056616554, 0.02053525026457146, 0.01778279410038923, 0.01539926526059492, 0.01333521432163324, 0.011547819846894581, 0.01, 0.008659643233600654, 0.007498942093324558, 0.006493816315762113, 0.005623413251903491, 0.004869675251658631, 0.004216965034285823, 0.003651741272548377, 0.0031622776601683794, 0.0027384196342643613, 0.0023713737056616554, 0.002053525026457146, 0.0017782794100389228, 0.001539926526059492, 0.001333521432163324, 0.0011547819846894581, 0.001, 0.0008659643233600654, 0.0007498942093324559, 0.0006493816315762113, 0.0005623413251903491, 0.0004869675251658631, 0.00042169650342858224, 0.0003651741272548377, 0.00031622776601683794, 0.0002738419634264361, 0.00023713737056616554, 0.0002053525026457146, 0.00017782794100389227, 0.0001539926526059492, 0.0001333521432163324, 0.00011547819846894582};

__device__ __forceinline__ void p0_transpose_item(const float* W, int K, int N, bf16* WT, LAS float* scr, int item, int lane) {
    const int nblk = N / 32, kb = item / nblk, nb = item % nblk, k0 = 64 * kb, n0 = 32 * nb;
    f32x4 v[8];
#pragma unroll
    for (int i = 0; i < 8; ++i) v[i] = *(const GAS f32x4*)(W + (size_t)(k0 + (lane >> 3) + 8 * i) * N + n0 + 4 * (lane & 7));
#pragma unroll
    for (int i = 0; i < 8; ++i) { const int kk = (lane >> 3) + 8 * i; LAS float* d = scr + (4 * (lane & 7)) * 68 + kk; d[0] = v[i].x; d[68] = v[i].y; d[2 * 68] = v[i].z; d[3 * 68] = v[i].w; }
    LDS_WAIT(); asm volatile("" ::: "memory");
    const int c = lane & 7;
#pragma unroll
    for (int j = 0; j < 4; ++j) { const int n = (lane >> 3) + 8 * j; const LAS f32x4* s = (const LAS f32x4*)(scr + n * 68 + 8 * c); const f32x4 a = s[0], bq = s[1];
        v4u o; o.x = pk2(a.x, a.y); o.y = pk2(a.z, a.w); o.z = pk2(bq.x, bq.y); o.w = pk2(bq.z, bq.w);
        const int nn = n0 + n, kg = k0 + 8 * c;
        *(GAS v4u*)(WT + ((size_t)((nn >> 8) * (K >> 6) + (kg >> 6)) * 256 + (nn & 255)) * 64 + (kg & 63)) = o; }
    LDS_WAIT(); asm volatile("" ::: "memory");
}
__device__ __forceinline__ void rms_row_to_bf16(int lane, const float* xrow, const float* w, bf16* orow, int m) {
    const GAS f32x4* xr = (const GAS f32x4*)xrow + lane;
    f32x4 v[16]; float s = 0.f;
#pragma unroll
    for (int j = 0; j < 16; ++j) { v[j] = xr[64 * j]; s += (v[j].x * v[j].x + v[j].y * v[j].y) + (v[j].z * v[j].z + v[j].w * v[j].w); }
    const float rstd = 1.f / sqrtf(wave_sum(s) * (1.f / D) + EPS);
    const GAS f32x4* wr = (const GAS f32x4*)w + lane;
#pragma unroll
    for (int hh = 0; hh < 2; ++hh) {
        f32x4 gv[8];
#pragma unroll
        for (int jj = 0; jj < 8; ++jj) gv[jj] = wr[64 * (8 * hh + jj)];
        asm volatile("" ::: "memory");
#pragma unroll
        for (int jj = 0; jj < 8; ++jj) { const int j = 8 * hh + jj; const f32x4 g = gv[jj]; v2u o; o.x = pk2(v[j].x * rstd * g.x, v[j].y * rstd * g.y); o.y = pk2(v[j].z * rstd * g.z, v[j].w * rstd * g.w);
            *(GAS v2u*)(orow + tiled_off(m, 4 * lane + 256 * j, D)) = o; }
    }
}

__device__ __forceinline__ void p0_prologue(Frame& F) {
    LAS float* scr = (LAS float*)(F.lds + RING_OFF + F.wave * 16384);
    const int gw = F.vcu * NWAVES + F.wave, NGW = F.G * NWAVES;
    constexpr int I_IN = (D / 64) * (NIN / 32), I_HP = (HW / 64) * (D / 32), I_AP = I_HP, I_OUT = (D / 64) * (D / 32), I_UP = (D / 64) * (DFF / 32), I_DN = (DFF / 64) * (D / 32), I_PLE = (PLE / 64) * (D / 32), I_PG = I_OUT;
    constexpr int NITEMS = I_IN + I_HP + I_AP + I_OUT + I_UP + I_DN + I_PLE + I_PG;
    unsigned char* ws = F.ws;
    for (int it = gw; it < NITEMS; it += NGW) {
        int r = it;
        if (r < I_IN) { p0_transpose_item(F.in[4], D, NIN, (bf16*)(ws + WS_WIN), scr, r, F.lane); continue; } r -= I_IN;
        if (r < I_HP) { p0_transpose_item(F.in[9], HW, D, (bf16*)(ws + WS_WHP), scr, r, F.lane); continue; } r -= I_HP;
        if (r < I_AP) { p0_transpose_item(F.in[10], HW, D, (bf16*)(ws + WS_WAP), scr, r, F.lane); continue; } r -= I_AP;
        if (r < I_OUT) { p0_transpose_item(F.in[11], D, D, (bf16*)(ws + WS_WOUT), scr, r, F.lane); continue; } r -= I_OUT;
        if (r < I_UP) { p0_transpose_item(F.in[14], D, DFF, (bf16*)(ws + WS_WUP), scr, r, F.lane); continue; } r -= I_UP;
        if (r < I_DN) { p0_transpose_item(F.in[15], DFF, D, (bf16*)(ws + WS_WDN), scr, r, F.lane); continue; } r -= I_DN;
        if (r < I_PLE) { p0_transpose_item(F.in[16], PLE, D, (bf16*)(ws + WS_WPLE), scr, r, F.lane); continue; } r -= I_PLE;
        p0_transpose_item(F.in[17], D, D, (bf16*)(ws + WS_WPG), scr, r, F.lane);
    }
    for (int m = gw; m < M; m += NGW) rms_row_to_bf16(F.lane, F.in[0] + (size_t)m * D, F.in[2], (bf16*)(ws + WS_XN), m);
    { const GAS f32x4* p4 = (const GAS f32x4*)F.in[1]; GAS v2u* o = (GAS v2u*)(ws + WS_PBF);
      for (size_t i = (size_t)gw * 64 + F.lane; i < (size_t)M * PLE / 4; i += (size_t)NGW * 64) { const f32x4 v = p4[i]; v2u w; w.x = pk2(v.x, v.y); w.y = pk2(v.z, v.w);
          *(GAS v2u*)((bf16*)o + tiled_off((int)(i >> 6), (int)(i & 63) * 4, PLE)) = w; } }
    { float* ct = (float*)(ws + WS_ROPE); float* st = ct + SEQ * 64;
      for (int i = gw * 64 + F.lane; i < SEQ * 64; i += NGW * 64) {
          const int pos = i >> 6, fi = i & 63;
          const double x = (double)pos * INV_FREQ[fi];
          const double k = __builtin_rint(x * 0.63661977236758134308);
          double r = __builtin_fma(-k, 1.57079632679489655800e+00, x); r = __builtin_fma(-k, 6.12323399573676603587e-17, r);
          const double r2 = r * r;
          double sp = -1.0 / 1307674368000.0; sp = sp * r2 + 1.0 / 6227020800.0; sp = sp * r2 - 1.0 / 39916800.0; sp = sp * r2 + 1.0 / 362880.0; sp = sp * r2 - 1.0 / 5040.0; sp = sp * r2 + 1.0 / 120.0; sp = sp * r2 - 1.0 / 6.0; sp = sp * r2 + 1.0;
          const double sn = sp * r;
          double cp = 1.0 / 20922789888000.0; cp = cp * r2 - 1.0 / 87178291200.0; cp = cp * r2 + 1.0 / 479001600.0; cp = cp * r2 - 1.0 / 3628800.0; cp = cp * r2 + 1.0 / 40320.0; cp = cp * r2 - 1.0 / 720.0; cp = cp * r2 + 1.0 / 24.0; cp = cp * r2 - 0.5; cp = cp * r2 + 1.0;
          const int q = (int)((long long)k & 3);
          const double cs = (q == 0) ? cp : (q == 1) ? -sn : (q == 2) ? -cp : sn;
          const double ss = (q == 0) ? sn : (q == 1) ? cp : (q == 2) ? -sn : -cp;
          ct[i] = (float)cs; st[i] = (float)ss;
      } }
    { float* lbf = (float*)(ws + WS_LB); float* lbb = lbf + HW;
      for (int i = gw * 64 + F.lane; i < 2 * HW; i += NGW * 64) {
          const float* src = (i < HW) ? F.in[5] : F.in[6]; const int c = (i < HW) ? i : i - HW;
          const float a = src[c], b = src[HW + c];
          const float l = 1.f / (1.f + expf(b - a));
          if (i < HW) lbf[c] = l; else lbb[c] = l;
      } }
}

namespace att {
typedef float f32x16 __attribute__((ext_vector_type(16)));
typedef short bf16x8 __attribute__((ext_vector_type(8)));
typedef short s16x4 __attribute__((ext_vector_type(4)));
typedef short v4i16_t __attribute__((ext_vector_type(4)));
constexpr int KST = 272, VST = 320;
constexpr int KBYTES = 64 * KST, VBYTES = 64 * VST, BUFB = KBYTES + VBYTES;
constexpr float SCL = 0.08838834764831845f * 1.4426950408889634f;
__device__ __forceinline__ s16x4 vtr(const LAS unsigned char* p) { return __builtin_bit_cast(s16x4, __builtin_amdgcn_ds_read_tr16_b64_v4i16((LAS v4i16_t*)p)); }
__device__ __forceinline__ bf16x8 pack8(const float* v) { v4u r; r.x = pg8::cvt_pk_bf16(v[0], v[1]); r.y = pg8::cvt_pk_bf16(v[2], v[3]); r.z = pg8::cvt_pk_bf16(v[4], v[5]); r.w = pg8::cvt_pk_bf16(v[6], v[7]); return __builtin_bit_cast(bf16x8, r); }
struct Pre { v4u k1, k2, v1, v2; f32x4 c0, c1, s0, s1; };
__device__ __forceinline__ void load_tile(Pre& P, const bf16* proj, const float* ct, const float* st, int b, int kvh, int j0, int tid) {
    const int key = tid >> 3, cp = tid & 7, j = j0 + key;
    const size_t ro = ((size_t)(b * NKV + kvh) * SEQ + j) * 128 + 8 * cp;
    const bf16* kr = proj + (WS_ATK - WS_PROJ) / 2 + ro; const bf16* vr = proj + (WS_ATV - WS_PROJ) / 2 + ro;
    P.k1 = *(const GAS v4u*)(kr); P.k2 = *(const GAS v4u*)(kr + 64);
    P.v1 = *(const GAS v4u*)(vr); P.v2 = *(const GAS v4u*)(vr + 64);
    P.c0 = *(const GAS f32x4*)(ct + j * 64 + 8 * cp); P.c1 = *(const GAS f32x4*)(ct + j * 64 + 8 * cp + 4);
    P.s0 = *(const GAS f32x4*)(st + j * 64 + 8 * cp); P.s1 = *(const GAS f32x4*)(st + j * 64 + 8 * cp + 4);
}
__device__ __forceinline__ void rot8(v4u a, v4u b, f32x4 c0, f32x4 c1, f32x4 s0, f32x4 s1, v4u& y1, v4u& y2) {
    const float x1[8] = {blo(a.x), bhi(a.x), blo(a.y), bhi(a.y), blo(a.z), bhi(a.z), blo(a.w), bhi(a.w)};
    const float x2[8] = {blo(b.x), bhi(b.x), blo(b.y), bhi(b.y), blo(b.z), bhi(b.z), blo(b.w), bhi(b.w)};
    const float c[8] = {c0.x, c0.y, c0.z, c0.w, c1.x, c1.y, c1.z, c1.w}, s[8] = {s0.x, s0.y, s0.z, s0.w, s1.x, s1.y, s1.z, s1.w};
    float r1[8], r2[8];
#pragma unroll
    for (int j = 0; j < 8; ++j) { r1[j] = x1[j] * c[j] - x2[j] * s[j]; r2[j] = x2[j] * c[j] + x1[j] * s[j]; }
    y1.x = pg8::cvt_pk_bf16(r1[0], r1[1]); y1.y = pg8::cvt_pk_bf16(r1[2], r1[3]); y1.z = pg8::cvt_pk_bf16(r1[4], r1[5]); y1.w = pg8::cvt_pk_bf16(r1[6], r1[7]);
    y2.x = pg8::cvt_pk_bf16(r2[0], r2[1]); y2.y = pg8::cvt_pk_bf16(r2[2], r2[3]); y2.z = pg8::cvt_pk_bf16(r2[4], r2[5]); y2.w = pg8::cvt_pk_bf16(r2[6], r2[7]);
}
__device__ __forceinline__ void store_tile(const Pre& P, LAS unsigned char* buf, int tid) {
    const int key = tid >> 3, cp = tid & 7;
    v4u y1, y2; rot8(P.k1, P.k2, P.c0, P.c1, P.s0, P.s1, y1, y2);
    *(LAS v4u*)(buf + key * KST + 16 * cp) = y1; *(LAS v4u*)(buf + key * KST + 128 + 16 * cp) = y2;
    *(LAS v4u*)(buf + KBYTES + key * VST + 16 * cp) = P.v1; *(LAS v4u*)(buf + KBYTES + key * VST + 128 + 16 * cp) = P.v2;
}
__device__ __forceinline__ void attn_unit(Frame& F, int u) {
    const int tid = F.tid, lane = F.lane, w = F.wave;
    const int qb = u & 127, kvh = (u >> 7) & 3, b = u >> 9;
    const int q0 = qb * 64, g = w >> 1, rh = w & 1, hh = kvh * 4 + g;
    const int ql = lane & 31, h = lane >> 5, rr = 32 * rh + ql, irow = q0 + rr;
    const bf16* proj = (const bf16*)(F.ws + WS_PROJ);
    const float* ct = (const float*)(F.ws + WS_ROPE); const float* st = ct + SEQ * 64;
    LAS unsigned char* lds = F.lds + RING_OFF;
    const int tlo = (q0 >= 128) ? 0 : ((q0 >= 64) ? 1 : 2), thi = (q0 + 192 <= SEQ) ? 4 : ((q0 + 128 <= SEQ) ? 3 : 2);
    Pre P;
    load_tile(P, proj, ct, st, b, kvh, q0 - 128 + 64 * tlo, tid);
    bf16x8 qf[8];
    { const bf16* qrow = proj + (WS_ATQ - WS_PROJ) / 2 + ((size_t)(b * NH + hh) * SEQ + irow) * 128;
#pragma unroll
      for (int ks = 0; ks < 4; ++ks) {
          const v4u a = *(const GAS v4u*)(qrow + 16 * ks + 8 * h), bb = *(const GAS v4u*)(qrow + 64 + 16 * ks + 8 * h);
          const float* cp_ = ct + irow * 64 + 16 * ks + 8 * h; const float* sp_ = st + irow * 64 + 16 * ks + 8 * h;
          v4u y1, y2; rot8(a, bb, *(const GAS f32x4*)cp_, *(const GAS f32x4*)(cp_ + 4), *(const GAS f32x4*)sp_, *(const GAS f32x4*)(sp_ + 4), y1, y2);
          qf[ks] = __builtin_bit_cast(bf16x8, y1); qf[ks + 4] = __builtin_bit_cast(bf16x8, y2);
      } }
    const float sinkL = F.in[8][hh] * 1.4426950408889634f;
    float mrun = sinkL, lrun = (h == 0) ? 1.f : 0.f;
    f32x16 O[4];
#pragma unroll
    for (int dt = 0; dt < 4; ++dt)
#pragma unroll
        for (int r = 0; r < 16; ++r) O[dt][r] = 0.f;
    store_tile(P, lds + (tlo & 1) * BUFB, tid);
    __syncthreads();
    const int q4 = (lane & 15) >> 2, p4 = lane & 3, dblk = (lane >> 4) & 1;
    for (int t = tlo; t <= thi; ++t) {
        const LAS unsigned char* Kb = lds + (t & 1) * BUFB; const LAS unsigned char* Vb = Kb + KBYTES;
        if (t < thi) load_tile(P, proj, ct, st, b, kvh, q0 - 128 + 64 * (t + 1), tid);
        f32x16 sT[2];
#pragma unroll
        for (int kt = 0; kt < 2; ++kt) {
#pragma unroll
            for (int r = 0; r < 16; ++r) sT[kt][r] = 0.f;
#pragma unroll
            for (int ks = 0; ks < 8; ++ks) {
                const bf16x8 kf = *(const LAS bf16x8*)(Kb + (32 * kt + ql) * KST + (16 * ks + 8 * h) * 2);
                sT[kt] = __builtin_amdgcn_mfma_f32_32x32x16_bf16(kf, qf[ks], sT[kt], 0, 0, 0);
            }
        }
        float tmax = -INFINITY;
#pragma unroll
        for (int kt = 0; kt < 2; ++kt)
#pragma unroll
            for (int r = 0; r < 16; ++r) {
                const int kk = 32 * kt + (r & 3) + 8 * (r >> 2) + 4 * h;
                float v = sT[kt][r] * SCL;
                if (t == 0 && kk < rr) v = -INFINITY;
                if (t == 4 && kk > rr) v = -INFINITY;
                sT[kt][r] = v; tmax = fmaxf(tmax, v);
            }
        tmax = fmaxf(tmax, __shfl_xor(tmax, 32));
        const float mnew = fmaxf(mrun, tmax), alpha = __builtin_amdgcn_exp2f(mrun - mnew);
        mrun = mnew; lrun *= alpha;
        if (!__all(alpha == 1.f)) {
#pragma unroll
            for (int dt = 0; dt < 4; ++dt)
#pragma unroll
                for (int r = 0; r < 16; ++r) O[dt][r] *= alpha;
        }
        bf16x8 pf[2][2];
#pragma unroll
        for (int kt = 0; kt < 2; ++kt) {
            float pv[16];
#pragma unroll
            for (int r = 0; r < 16; ++r) { pv[r] = __builtin_amdgcn_exp2f(sT[kt][r] - mnew); lrun += pv[r]; }
            pf[kt][0] = pack8(pv); pf[kt][1] = pack8(pv + 8);
        }
#pragma unroll
        for (int dt = 0; dt < 4; ++dt)
#pragma unroll
            for (int kt = 0; kt < 2; ++kt)
#pragma unroll
                for (int s2 = 0; s2 < 2; ++s2) {
                    const LAS unsigned char* a = Vb + (32 * kt + 16 * s2 + 4 * h + q4) * VST + (32 * dt + 16 * dblk + 4 * p4) * 2;
                    const s16x4 lo = vtr(a), hi = vtr(a + 8 * VST);
                    const bf16x8 vf = __builtin_shufflevector(lo, hi, 0, 1, 2, 3, 4, 5, 6, 7);
                    O[dt] = __builtin_amdgcn_mfma_f32_32x32x16_bf16(vf, pf[kt][s2], O[dt], 0, 0, 0);
                }
        if (t < thi) store_tile(P, lds + ((t + 1) & 1) * BUFB, tid);
        __syncthreads();
    }
    const float ltot = lrun + __shfl_xor(lrun, 32), inv = 1.f / ltot;
    bf16* xnb = (bf16*)(F.ws + WS_XN); const int orow_m = b * SEQ + irow, ocol0 = HW + hh * 128;
#pragma unroll
    for (int dt = 0; dt < 4; ++dt)
#pragma unroll
        for (int rg = 0; rg < 4; ++rg) {
            v2u o; o.x = pg8::cvt_pk_bf16(O[dt][4 * rg] * inv, O[dt][4 * rg + 1] * inv); o.y = pg8::cvt_pk_bf16(O[dt][4 * rg + 2] * inv, O[dt][4 * rg + 3] * inv);
            *(GAS v2u*)(xnb + tiled_off(orow_m, ocol0 + 32 * dt + 8 * rg + 4 * h, D)) = o;
        }
}
}

namespace scn {
using att::f32x16; using att::bf16x8; using att::s16x4; using att::vtr; using att::pack8;
constexpr int QST = 272, TST = 320;
constexpr int QH_OFF = 0, KH_OFF = 64 * QST, KT_OFF = KH_OFF + 64 * QST, VV_OFF = KT_OFF + 64 * TST, ST_OFF = VV_OFF + 64 * TST, DEC_OFF = ST_OFF + 128 * QST, TOT_OFF = DEC_OFF + 512, FLAG_OFF = TOT_OFF + 8 * 128 * 4, END_OFF = FLAG_OFF + 16;
static_assert(END_OFF <= RING_BYTES, "scan LDS map");
struct Raw { v4u q1, q2, s1, s2, v1, v2; };
__device__ __forceinline__ void load_raw(Raw& R, const bf16* proj, int b, int h, int dir, int n, int tid) {
    const int i = tid >> 3, cp = tid & 7, tau = 64 * n + i, t = dir ? (SEQ - 1 - tau) : tau;
    const bf16* row = proj + ((size_t)(b * NH + h) * SEQ + t) * 128 + 8 * cp;
    const size_t C_HQ = (WS_SQ - WS_PROJ) / 2, C_HI = (WS_SV - WS_PROJ) / 2;
    const size_t cf = (dir ? (WS_SFB - WS_PROJ) : (WS_SFF - WS_PROJ)) / 2;
    R.q1 = *(const GAS v4u*)(row + C_HQ); R.q2 = *(const GAS v4u*)(row + C_HQ + 64);
    R.s1 = *(const GAS v4u*)(row + cf); R.s2 = *(const GAS v4u*)(row + cf + 64);
    R.v1 = *(const GAS v4u*)(row + C_HI); R.v2 = *(const GAS v4u*)(row + C_HI + 64);
}
__device__ __forceinline__ void store_raw(const Raw& R, LAS unsigned char* lds, int tid) {
    const int i = tid >> 3, cp = tid & 7;
    *(LAS v4u*)(lds + QH_OFF + i * QST + 16 * cp) = R.q1; *(LAS v4u*)(lds + QH_OFF + i * QST + 128 + 16 * cp) = R.q2;
    *(LAS v4u*)(lds + KH_OFF + i * QST + 16 * cp) = R.s1; *(LAS v4u*)(lds + KH_OFF + i * QST + 128 + 16 * cp) = R.s2;
    *(LAS v4u*)(lds + VV_OFF + i * TST + 16 * cp) = R.v1; *(LAS v4u*)(lds + VV_OFF + i * TST + 128 + 16 * cp) = R.v2;
}
struct Ctx { LAS unsigned char* lds; const bf16* proj; bf16* Og; int b, hd, dir, tid, ct, vt, ql, h, q4, p4, dblk, kp, sg, nend; float oml0, oml1; };
#define LBAR() do { asm volatile("s_waitcnt lgkmcnt(0)" ::: "memory"); __builtin_amdgcn_s_barrier(); asm volatile("" ::: "memory"); } while (0)
__device__ __forceinline__ void scan_step(const Ctx& C, f32x16 (&S)[2], float (&DT)[2], const Raw& Rst, Raw& Rld, const int n) {
    LAS unsigned char* lds = C.lds; const bf16* proj = C.proj; bf16* Og = C.Og;
    const int b = C.b, hd = C.hd, dir = C.dir, tid = C.tid, ct = C.ct, vt = C.vt, ql = C.ql, h = C.h, q4 = C.q4, p4 = C.p4, dblk = C.dblk, kp = C.kp, sg = C.sg;
    const float oml0 = C.oml0, oml1 = C.oml1;
        float qv0[8], qv1[8], kk0[8], kk1[8], pp0[8], pp1[8];
        { float run0 = 1.f, run1 = 1.f;
#pragma unroll
          for (int ii = 0; ii < 8; ++ii) {
              const int i = 8 * sg + ii;
              const unsigned qr = *(const LAS unsigned*)(lds + QH_OFF + i * QST + 4 * kp), sr = *(const LAS unsigned*)(lds + KH_OFF + i * QST + 4 * kp);
              qv0[ii] = blo(qr); qv1[ii] = bhi(qr);
              kk0[ii] = oml0 * blo(sr); kk1[ii] = oml1 * bhi(sr);
              run0 *= (1.f - kk0[ii]); run1 *= (1.f - kk1[ii]);
              pp0[ii] = run0; pp1[ii] = run1;
          }
          *(LAS f32x2*)(lds + TOT_OFF + (sg * 128 + 2 * kp) * 4) = (f32x2){run0, run1}; }
        LBAR();
        { float pre0 = 1.f, pre1 = 1.f, all0 = 1.f, all1 = 1.f;
#pragma unroll
          for (int s_ = 0; s_ < 8; ++s_) { const f32x2 T = *(const LAS f32x2*)(lds + TOT_OFF + (s_ * 128 + 2 * kp) * 4); all0 *= T.x; all1 *= T.y; if (s_ < sg) { pre0 *= T.x; pre1 *= T.y; } }
#pragma unroll
          for (int ii = 0; ii < 8; ++ii) {
              const int i = 8 * sg + ii;
              const float P0 = pre0 * pp0[ii], P1 = pre1 * pp1[ii];
              const float r0 = __builtin_amdgcn_rcpf(P0), r1 = __builtin_amdgcn_rcpf(P1);
              const float kh0 = kk0[ii] * r0, kh1 = kk1[ii] * r1;
              *(LAS unsigned*)(lds + QH_OFF + i * QST + 4 * kp) = pg8::cvt_pk_bf16(qv0[ii] * P0, qv1[ii] * P1);
              *(LAS unsigned*)(lds + KH_OFF + i * QST + 4 * kp) = pg8::cvt_pk_bf16(kh0, kh1);
              *(LAS unsigned*)(lds + KT_OFF + i * TST + 4 * kp) = pg8::cvt_pk_bf16(kh0 * all0, kh1 * all1);
          }
          DT[0] *= all0; DT[1] *= all1;
          if (sg == 0) *(LAS f32x2*)(lds + DEC_OFF + 2 * kp * 4) = (f32x2){all0, all1}; }
        LBAR();
        if (n + 2 < C.nend) load_raw(Rld, proj, b, hd, dir, n + 2, tid);
        bf16x8 qa[8], sf[8], kf0[8];
#pragma unroll
        for (int ks = 0; ks < 8; ++ks) qa[ks] = *(const LAS bf16x8*)(lds + QH_OFF + (32 * ct + ql) * QST + (16 * ks + 8 * h) * 2);
#pragma unroll
        for (int ks = 0; ks < 8; ++ks) sf[ks] = *(const LAS bf16x8*)(lds + ST_OFF + (32 * vt + ql) * QST + (16 * ks + 8 * h) * 2);
#pragma unroll
        for (int ks = 0; ks < 8; ++ks) kf0[ks] = *(const LAS bf16x8*)(lds + KH_OFF + ql * QST + (16 * ks + 8 * h) * 2);
        asm volatile("" ::: "memory");
        f32x16 OT;
#pragma unroll
        for (int r = 0; r < 16; ++r) OT[r] = 0.f;
#pragma unroll
        for (int ks = 0; ks < 8; ++ks) OT = __builtin_amdgcn_mfma_f32_32x32x16_bf16(sf[ks], qa[ks], OT, 0, 0, 0);
        {
            const LAS unsigned char* va = lds + VV_OFF + (4 * h + q4) * TST + (32 * vt + 16 * dblk + 4 * p4) * 2;
            const s16x4 v0lo = vtr(va), v0hi = vtr(va + 8 * TST), v1lo = vtr(va + 16 * TST), v1hi = vtr(va + 24 * TST);
            asm volatile("" ::: "memory");
            f32x16 X;
#pragma unroll
            for (int r = 0; r < 16; ++r) X[r] = 0.f;
#pragma unroll
            for (int ks = 0; ks < 8; ++ks) X = __builtin_amdgcn_mfma_f32_32x32x16_bf16(kf0[ks], qa[ks], X, 0, 0, 0);
            float xv[16];
#pragma unroll
            for (int r = 0; r < 16; ++r) { const int sl = (r & 3) + 8 * (r >> 2) + 4 * h; xv[r] = (ct > 0 || sl <= ql) ? X[r] : 0.f; }
            OT = __builtin_amdgcn_mfma_f32_32x32x16_bf16(__builtin_shufflevector(v0lo, v0hi, 0, 1, 2, 3, 4, 5, 6, 7), pack8(xv), OT, 0, 0, 0);
            OT = __builtin_amdgcn_mfma_f32_32x32x16_bf16(__builtin_shufflevector(v1lo, v1hi, 0, 1, 2, 3, 4, 5, 6, 7), pack8(xv + 8), OT, 0, 0, 0);
        }
        if (ct > 0) {
            bf16x8 kf1[8];
#pragma unroll
            for (int ks = 0; ks < 8; ++ks) kf1[ks] = *(const LAS bf16x8*)(lds + KH_OFF + (32 + ql) * QST + (16 * ks + 8 * h) * 2);
            const LAS unsigned char* va = lds + VV_OFF + (32 + 4 * h + q4) * TST + (32 * vt + 16 * dblk + 4 * p4) * 2;
            const s16x4 v0lo = vtr(va), v0hi = vtr(va + 8 * TST), v1lo = vtr(va + 16 * TST), v1hi = vtr(va + 24 * TST);
            asm volatile("" ::: "memory");
            f32x16 X;
#pragma unroll
            for (int r = 0; r < 16; ++r) X[r] = 0.f;
#pragma unroll
            for (int ks = 0; ks < 8; ++ks) X = __builtin_amdgcn_mfma_f32_32x32x16_bf16(kf1[ks], qa[ks], X, 0, 0, 0);
            float xv[16];
#pragma unroll
            for (int r = 0; r < 16; ++r) { const int sl = (r & 3) + 8 * (r >> 2) + 4 * h; xv[r] = (sl <= ql) ? X[r] : 0.f; }
            OT = __builtin_amdgcn_mfma_f32_32x32x16_bf16(__builtin_shufflevector(v0lo, v0hi, 0, 1, 2, 3, 4, 5, 6, 7), pack8(xv), OT, 0, 0, 0);
            OT = __builtin_amdgcn_mfma_f32_32x32x16_bf16(__builtin_shufflevector(v1lo, v1hi, 0, 1, 2, 3, 4, 5, 6, 7), pack8(xv + 8), OT, 0, 0, 0);
        }
        {
            bf16x8 vbf[4], kaf[2][4]; f32x4 d4[2][4];
#pragma unroll
            for (int cs = 0; cs < 4; ++cs) {
                const LAS unsigned char* vb_ = lds + VV_OFF + (16 * cs + 8 * h + q4) * TST + (32 * vt + 16 * dblk + 4 * p4) * 2;
                const s16x4 vlo = vtr(vb_), vhi = vtr(vb_ + 4 * TST);
                vbf[cs] = __builtin_shufflevector(vlo, vhi, 0, 1, 2, 3, 4, 5, 6, 7);
#pragma unroll
                for (int j = 0; j < 2; ++j) {
                    const LAS unsigned char* ka = lds + KT_OFF + (16 * cs + 8 * h + q4) * TST + (32 * (2 * ct + j) + 16 * dblk + 4 * p4) * 2;
                    const s16x4 klo = vtr(ka), khi = vtr(ka + 4 * TST);
                    kaf[j][cs] = __builtin_shufflevector(klo, khi, 0, 1, 2, 3, 4, 5, 6, 7);
                }
            }
#pragma unroll
            for (int j = 0; j < 2; ++j)
#pragma unroll
                for (int rg = 0; rg < 4; ++rg) d4[j][rg] = *(const LAS f32x4*)(lds + DEC_OFF + (32 * (2 * ct + j) + 8 * rg + 4 * h) * 4);
            asm volatile("" ::: "memory");
#pragma unroll
            for (int j = 0; j < 2; ++j)
#pragma unroll
                for (int rg = 0; rg < 4; ++rg) { S[j][4 * rg] *= d4[j][rg].x; S[j][4 * rg + 1] *= d4[j][rg].y; S[j][4 * rg + 2] *= d4[j][rg].z; S[j][4 * rg + 3] *= d4[j][rg].w; }
#pragma unroll
            for (int cs = 0; cs < 4; ++cs)
#pragma unroll
                for (int j = 0; j < 2; ++j) S[j] = __builtin_amdgcn_mfma_f32_32x32x16_bf16(kaf[j][cs], vbf[cs], S[j], 0, 0, 0);
        }
        { const int tau = 64 * n + 32 * ct + ql, t = dir ? (SEQ - 1 - tau) : tau;
          bf16* orow = Og + (size_t)(b * SEQ + t) * HW + hd * 128 + 32 * vt;
#pragma unroll
          for (int rg = 0; rg < 4; ++rg) { v2u o; o.x = pg8::cvt_pk_bf16(OT[4 * rg], OT[4 * rg + 1]); o.y = pg8::cvt_pk_bf16(OT[4 * rg + 2], OT[4 * rg + 3]); *(GAS v2u*)(orow + 8 * rg + 4 * h) = o; } }
        LBAR();
#pragma unroll
        for (int j = 0; j < 2; ++j) {
            const int kt = 2 * ct + j;
#pragma unroll
            for (int rg = 0; rg < 4; ++rg) { v2u o; o.x = pg8::cvt_pk_bf16(S[j][4 * rg], S[j][4 * rg + 1]); o.y = pg8::cvt_pk_bf16(S[j][4 * rg + 2], S[j][4 * rg + 3]);
                *(LAS v2u*)(lds + ST_OFF + (32 * vt + ql) * QST + (32 * kt + 8 * rg + 4 * h) * 2) = o; }
        }
        if (n + 1 < C.nend) store_raw(Rst, lds, tid);
        LBAR();
}
constexpr int NSEG = 4, SEGC = (SEQ / 64) / NSEG;
__device__ __forceinline__ void scan_unit(Frame& F, int unit) {
    const int seg = unit & (NSEG - 1), bhd = unit >> 2;
    const int b = bhd >> 5, hd = (bhd >> 1) & 15, dir = bhd & 1;
    const int tid = F.tid, lane = F.lane, w = F.wave;
    LAS unsigned char* lds = F.lds + RING_OFF;
    const bf16* proj = (const bf16*)(F.ws + WS_PROJ);
    bf16* Og = (bf16*)(F.ws + (dir ? WS_OB : WS_OF));
    const float* lb = (const float*)(F.ws + WS_LB) + (dir ? HW : 0) + hd * 128;
    const int ct = w >> 2, vt = w & 3, ql = lane & 31, h = lane >> 5;
    const int q4 = (lane & 15) >> 2, p4 = lane & 3, dblk = (lane >> 4) & 1;
    const int kp = lane, sg = w;
    const float oml0 = 1.f - lb[2 * kp], oml1 = 1.f - lb[2 * kp + 1];
    for (int e = tid; e < 128 * QST / 16; e += 512) *(LAS v4u*)(lds + ST_OFF + 16 * e) = (v4u){0u, 0u, 0u, 0u};
    f32x16 S[2];
#pragma unroll
    for (int j = 0; j < 2; ++j)
#pragma unroll
        for (int r = 0; r < 16; ++r) S[j][r] = 0.f;
    float DT[2] = {1.f, 1.f};
    const int n0 = seg * SEGC, n1 = n0 + SEGC;
    Raw RA, RB;
    load_raw(RA, proj, b, hd, dir, n0, tid);
    load_raw(RB, proj, b, hd, dir, n0 + 1, tid);
    store_raw(RA, lds, tid);
    __syncthreads();
    Ctx C; C.lds = lds; C.proj = proj; C.Og = Og; C.b = b; C.hd = hd; C.dir = dir; C.tid = tid; C.ct = ct; C.vt = vt; C.ql = ql; C.h = h; C.q4 = q4; C.p4 = p4; C.dblk = dblk; C.kp = kp; C.sg = sg; C.nend = n1; C.oml0 = oml0; C.oml1 = oml1;
    for (int n = n0; n < n1; n += 2) {
        scan_step(C, S, DT, RB, RA, n);
        scan_step(C, S, DT, RA, RB, n + 1);
    }
    { GAS f32x4* send = (GAS f32x4*)(F.ws + WS_SEND) + (size_t)unit * 4096;
#pragma unroll
      for (int j = 0; j < 2; ++j)
#pragma unroll
          for (int rg = 0; rg < 4; ++rg) send[((w * 2 + j) * 4 + rg) * 64 + lane] = (f32x4){S[j][4 * rg], S[j][4 * rg + 1], S[j][4 * rg + 2], S[j][4 * rg + 3]};
      if (w == 0) *(GAS f32x2*)((float*)(F.ws + WS_DTOT) + unit * 128 + 2 * kp) = (f32x2){DT[0], DT[1]}; }
}
__device__ __forceinline__ void fixup_unit(Frame& F, int unit) {
    const int seg = unit & (NSEG - 1), bhd = unit >> 2;
    const int b = bhd >> 5, hd = (bhd >> 1) & 15, dir = bhd & 1;
    const int tid = F.tid, lane = F.lane, w = F.wave;
    LAS unsigned char* lds = F.lds + RING_OFF;
    const bf16* proj = (const bf16*)(F.ws + WS_PROJ);
    bf16* Og = (bf16*)(F.ws + (dir ? WS_OB : WS_OF));
    const float* lb = (const float*)(F.ws + WS_LB) + (dir ? HW : 0) + hd * 128;
    const int ct = w >> 2, vt = w & 3, ql = lane & 31, h = lane >> 5;
    const int kp = lane, sg = w;
    const float oml0 = 1.f - lb[2 * kp], oml1 = 1.f - lb[2 * kp + 1];
    f32x16 S[2];
    { const GAS f32x4* send = (const GAS f32x4*)(F.ws + WS_SEND) + (size_t)(bhd * NSEG) * 4096;
      const float* dtot = (const float*)(F.ws + WS_DTOT) + (size_t)(bhd * NSEG) * 128;
#pragma unroll
      for (int j = 0; j < 2; ++j)
#pragma unroll
          for (int rg = 0; rg < 4; ++rg) { const f32x4 e = send[((w * 2 + j) * 4 + rg) * 64 + lane]; S[j][4 * rg] = e.x; S[j][4 * rg + 1] = e.y; S[j][4 * rg + 2] = e.z; S[j][4 * rg + 3] = e.w; }
      for (int g = 1; g < seg; ++g) {
#pragma unroll
          for (int j = 0; j < 2; ++j)
#pragma unroll
              for (int rg = 0; rg < 4; ++rg) { const f32x4 e = send[(size_t)g * 4096 + ((w * 2 + j) * 4 + rg) * 64 + lane]; const f32x4 d = *(const GAS f32x4*)(dtot + g * 128 + 32 * (2 * ct + j) + 8 * rg + 4 * h);
                  S[j][4 * rg] = d.x * S[j][4 * rg] + e.x; S[j][4 * rg + 1] = d.y * S[j][4 * rg + 1] + e.y; S[j][4 * rg + 2] = d.z * S[j][4 * rg + 2] + e.z; S[j][4 * rg + 3] = d.w * S[j][4 * rg + 3] + e.w; }
      } }
    float dc0 = 1.f, dc1 = 1.f;
    const int n0 = seg * SEGC, n1 = n0 + SEGC;
    for (int n = n0; n < n1; ++n) {
        __syncthreads();
#pragma unroll
        for (int j = 0; j < 2; ++j) {
            const int kt = 2 * ct + j;
#pragma unroll
            for (int rg = 0; rg < 4; ++rg) { v2u o; o.x = pg8::cvt_pk_bf16(S[j][4 * rg], S[j][4 * rg + 1]); o.y = pg8::cvt_pk_bf16(S[j][4 * rg + 2], S[j][4 * rg + 3]);
                *(LAS v2u*)(lds + ST_OFF + (32 * vt + ql) * QST + (32 * kt + 8 * rg + 4 * h) * 2) = o; }
        }
        { Raw R; load_raw(R, proj, b, hd, dir, n, tid); store_raw(R, lds, tid); }
        __syncthreads();
        float qv0[8], qv1[8], pp0[8], pp1[8];
        { float run0 = 1.f, run1 = 1.f;
#pragma unroll
          for (int ii = 0; ii < 8; ++ii) {
              const int i = 8 * sg + ii;
              const unsigned qr = *(const LAS unsigned*)(lds + QH_OFF + i * QST + 4 * kp), sr = *(const LAS unsigned*)(lds + KH_OFF + i * QST + 4 * kp);
              qv0[ii] = blo(qr); qv1[ii] = bhi(qr);
              run0 *= (1.f - oml0 * blo(sr)); run1 *= (1.f - oml1 * bhi(sr));
              pp0[ii] = run0; pp1[ii] = run1;
          }
          *(LAS f32x2*)(lds + TOT_OFF + (sg * 128 + 2 * kp) * 4) = (f32x2){run0, run1}; }
        __syncthreads();
        { float pre0 = 1.f, pre1 = 1.f, all0 = 1.f, all1 = 1.f;
#pragma unroll
          for (int s_ = 0; s_ < 8; ++s_) { const f32x2 T = *(const LAS f32x2*)(lds + TOT_OFF + (s_ * 128 + 2 * kp) * 4); all0 *= T.x; all1 *= T.y; if (s_ < sg) { pre0 *= T.x; pre1 *= T.y; } }
#pragma unroll
          for (int ii = 0; ii < 8; ++ii) { const int i = 8 * sg + ii;
              *(LAS unsigned*)(lds + QH_OFF + i * QST + 4 * kp) = pg8::cvt_pk_bf16(qv0[ii] * (pre0 * pp0[ii]), qv1[ii] * (pre1 * pp1[ii])); }
          if (sg == 0) { *(LAS f32x2*)(lds + DEC_OFF + 2 * kp * 4) = (f32x2){all0, all1};
              dc0 *= all0; dc1 *= all1;
              const bool any = __any((dc0 != 0.f) || (dc1 != 0.f)) != 0;
              if (lane == 0) *(LAS unsigned*)(lds + FLAG_OFF) = any ? 1u : 0u; } }
        __syncthreads();
        { bf16x8 qa[8], sf[8];
#pragma unroll
          for (int ks = 0; ks < 8; ++ks) qa[ks] = *(const LAS bf16x8*)(lds + QH_OFF + (32 * ct + ql) * QST + (16 * ks + 8 * h) * 2);
#pragma unroll
          for (int ks = 0; ks < 8; ++ks) sf[ks] = *(const LAS bf16x8*)(lds + ST_OFF + (32 * vt + ql) * QST + (16 * ks + 8 * h) * 2);
          f32x16 OT;
#pragma unroll
          for (int r = 0; r < 16; ++r) OT[r] = 0.f;
#pragma unroll
          for (int ks = 0; ks < 8; ++ks) OT = __builtin_amdgcn_mfma_f32_32x32x16_bf16(sf[ks], qa[ks], OT, 0, 0, 0);
          const int tau = 64 * n + 32 * ct + ql, t = dir ? (SEQ - 1 - tau) : tau;
          bf16* orow = Og + (size_t)(b * SEQ + t) * HW + hd * 128 + 32 * vt;
#pragma unroll
          for (int rg = 0; rg < 4; ++rg) { GAS v2u* p = (GAS v2u*)(orow + 8 * rg + 4 * h); const v2u old = *p;
              v2u o; o.x = pg8::cvt_pk_bf16(blo(old.x) + OT[4 * rg], bhi(old.x) + OT[4 * rg + 1]); o.y = pg8::cvt_pk_bf16(blo(old.y) + OT[4 * rg + 2], bhi(old.y) + OT[4 * rg + 3]); *p = o; } }
#pragma unroll
        for (int j = 0; j < 2; ++j)
#pragma unroll
            for (int rg = 0; rg < 4; ++rg) { const f32x4 d4 = *(const LAS f32x4*)(lds + DEC_OFF + (32 * (2 * ct + j) + 8 * rg + 4 * h) * 4);
                S[j][4 * rg] *= d4.x; S[j][4 * rg + 1] *= d4.y; S[j][4 * rg + 2] *= d4.z; S[j][4 * rg + 3] *= d4.w; }
        const unsigned more = *(const LAS unsigned*)(lds + FLAG_OFF);
        if (__builtin_amdgcn_readfirstlane(more) == 0u) break;
    }
    __syncthreads();
}
}

__device__ __forceinline__ void ohnorm_phase(Frame& F) {
    const int gw = F.vcu * NWAVES + F.wave, NGW = F.G * NWAVES, lane = F.lane;
    const bf16* of = (const bf16*)(F.ws + WS_OF); const bf16* ob = (const bf16*)(F.ws + WS_OB);
    const bf16* proj = (const bf16*)(F.ws + WS_PROJ);
    const float* hn = F.in[7] + (lane & 3) * 32;
    for (int m = gw; m < M; m += NGW) {
        const GAS v4u* a = (const GAS v4u*)(of + (size_t)m * HW + lane * 32);
        const GAS v4u* b = (const GAS v4u*)(ob + (size_t)m * HW + lane * 32);
        const GAS v4u* g = (const GAS v4u*)(proj + (WS_P2 - WS_PROJ) / 2 + (size_t)m * NP2 + C2_HG + lane * 32);
        bf16* xnb = (bf16*)(F.ws + WS_XN);
        float v[32]; float ss = 0.f;
#pragma unroll
        for (int q = 0; q < 4; ++q) { const v4u x = a[q], y = b[q];
            v[q * 8 + 0] = blo(x.x) + blo(y.x); v[q * 8 + 1] = bhi(x.x) + bhi(y.x); v[q * 8 + 2] = blo(x.y) + blo(y.y); v[q * 8 + 3] = bhi(x.y) + bhi(y.y);
            v[q * 8 + 4] = blo(x.z) + blo(y.z); v[q * 8 + 5] = bhi(x.z) + bhi(y.z); v[q * 8 + 6] = blo(x.w) + blo(y.w); v[q * 8 + 7] = bhi(x.w) + bhi(y.w); }
#pragma unroll
        for (int j = 0; j < 32; ++j) ss += v[j] * v[j];
        ss += __shfl_xor(ss, 1); ss += __shfl_xor(ss, 2);
        const float rstd = 1.f / sqrtf(ss * (1.f / 128.f) + EPS);
#pragma unroll
        for (int q = 0; q < 4; ++q) { const v4u z = g[q];
            float gg[8] = {blo(z.x), bhi(z.x), blo(z.y), bhi(z.y), blo(z.z), bhi(z.z), blo(z.w), bhi(z.w)};
            float r[8];
#pragma unroll
            for (int j = 0; j < 8; ++j) r[j] = v[q * 8 + j] * rstd * hn[q * 8 + j] * gg[j];
            v4u w; w.x = pk2(r[0], r[1]); w.y = pk2(r[2], r[3]); w.z = pk2(r[4], r[5]); w.w = pk2(r[6], r[7]); *(GAS v4u*)(xnb + tiled_off(m, lane * 32 + 8 * q, D)) = w; }
    }
}

template <int KIND>
__device__ __forceinline__ void resid_phase(Frame& F, const bf16* Y, const float* xin, const bf16* bin, bf16* XB, const float* wpost, const float* wpre) {
    const int gw = F.vcu * NWAVES + F.wave, NGW = F.G * NWAVES, lane = F.lane;
    const float* SS = (const float*)(F.ws + WS_SS);
#pragma nounroll
    for (int m = gw; m < M; m += NGW) {
        const GAS v2u* y2 = (const GAS v2u*)(Y + (size_t)m * D) + lane;
        const GAS f32x4* x4 = (const GAS f32x4*)(xin + (size_t)m * D) + lane;
        const GAS v2u* b2 = (const GAS v2u*)(bin + (size_t)m * D) + lane;
        const GAS f32x4* w4 = (const GAS f32x4*)wpost + lane;
        GAS f32x4* o4 = (GAS f32x4*)(F.out + (size_t)m * D) + lane;
        GAS v2u* xb = (GAS v2u*)(XB + (size_t)m * D) + lane;
        bf16* xnb = (bf16*)(F.ws + WS_XN);
        const float rstd = 1.f / sqrtf(wave_sum(SS[(size_t)m * 64 + lane]) * (1.f / D) + EPS);
        f32x4 v[16]; float s2 = 0.f;
#pragma unroll
        for (int hh = 0; hh < 2; ++hh) {
            v2u yv[8]; f32x4 wv[8];
#pragma unroll
            for (int jj = 0; jj < 8; ++jj) { const int j = 8 * hh + jj; yv[jj] = y2[64 * j]; wv[jj] = w4[64 * j];
                if (KIND == 0) v[j] = x4[64 * j];
                else { const v2u bb = (KIND == 2) ? *(const GAS v2u*)(bin + tiled_off(m, 4 * lane + 256 * j, D)) : b2[64 * j]; v[j] = (f32x4){blo(bb.x), bhi(bb.x), blo(bb.y), bhi(bb.y)}; } }
            asm volatile("" ::: "memory");
#pragma unroll
            for (int jj = 0; jj < 8; ++jj) { const int j = 8 * hh + jj; const v2u y = yv[jj]; const f32x4 w = wv[jj]; const f32x4 x = v[j];
                f32x4 r; r.x = x.x + blo(y.x) * rstd * w.x; r.y = x.y + bhi(y.x) * rstd * w.y; r.z = x.z + blo(y.y) * rstd * w.z; r.w = x.w + bhi(y.y) * rstd * w.w;
                if (KIND == 0) { v[j] = r; s2 += (r.x * r.x + r.y * r.y) + (r.z * r.z + r.w * r.w); v2u o; o.x = pk2(r.x, r.y); o.y = pk2(r.z, r.w); xb[64 * j] = o; }
                if (KIND == 1) { v2u o; o.x = pk2(r.x, r.y); o.y = pk2(r.z, r.w); *(GAS v2u*)(xnb + tiled_off(m, 4 * lane + 256 * j, D)) = o; }
                if (KIND == 2) o4[64 * j] = r; }
        }
        if (KIND == 0) {
            const float r2 = 1.f / sqrtf(wave_sum(s2) * (1.f / D) + EPS);
            const GAS f32x4* p4 = (const GAS f32x4*)wpre + lane;
#pragma unroll
            for (int j = 0; j < 16; ++j) { const f32x4 g = p4[64 * j];
                v2u o; o.x = pk2(v[j].x * r2 * g.x, v[j].y * r2 * g.y); o.y = pk2(v[j].z * r2 * g.z, v[j].w * r2 * g.w); *(GAS v2u*)(xnb + tiled_off(m, 4 * lane + 256 * j, D)) = o; }
        }
    }
}

struct Args { const float* in[19]; float* out; unsigned char* ws; int ph_lo, ph_hi, li, pad; };
__global__ void __launch_bounds__(NWAVES * 64, 2) skel_fwd(Args args) {
    extern __shared__ __attribute__((aligned(16))) unsigned char lds[];
    Frame F;
    F.lds = (LAS unsigned char*)lds;
    F.MISC = (volatile LAS unsigned*)(F.lds + MISC_OFF);
    F.tid = threadIdx.x; F.lane = F.tid & 63; F.wave = __builtin_amdgcn_readfirstlane(F.tid >> 6);
    F.G = gridDim.x; { const int bx = blockIdx.x; F.vcu = (F.G % 8 == 0) ? (bx % 8) * (F.G / 8) + bx / 8 : bx; }
    unsigned char* ws = args.ws; F.ws = ws;
    F.ctl = (gu32*)(ws + WS_CTL);
#pragma unroll
    for (int i = 0; i < 19; ++i) F.in[i] = args.in[i];
    F.out = args.out;
    for (int u = F.tid; u < (LDS_BYTES - LDSCTL_OFF) / 4; u += NWAVES * 64) ((LAS unsigned*)(F.lds + LDSCTL_OFF))[u] = 0u;
    __syncthreads();
    XcdBarrier bar; bar.bar = (unsigned*)(F.ctl + CW_BAR); bar.x = 0; bar.st = nullptr;
    if (ONE_LAUNCH) bar = xcd_barrier_post((unsigned*)(F.ctl + CW_BAR), F.MISC + 8);
#define GRID_BAR() do { if (ONE_LAUNCH) xcd_barrier(bar); } while (0)
#define SELF_ACQ() do { asm volatile("s_waitcnt vmcnt(0)" ::: "memory"); __syncthreads(); __builtin_amdgcn_fence(__ATOMIC_ACQUIRE, "agent"); asm volatile("s_waitcnt vmcnt(0)" ::: "memory"); __syncthreads(); } while (0)
    const int lo = args.ph_lo, hi = args.ph_hi;
#define IN(k) (lo <= (k) && (k) < hi)
#define BOTH(k) (IN(k) && IN((k) + 1))
    bf16* XN = (bf16*)(ws + WS_XN); bf16* P2 = (bf16*)(ws + WS_P2); float* SS = (float*)(ws + WS_SS);
    const int c = (int)blockIdx.x;

    if (IN(0)) { p0_prologue(F); if (BOTH(0)) GRID_BAR(); }
    if (IN(1)) {
        pg8::Gemm g{XN, (const bf16*)(ws + WS_WIN), M, NIN, D, D / 64, D}; pg8::StaticOrder S; S.init(M, NIN, F.G, c);
        pg8::Epi<6> E{P2, NP2, nullptr, 0, nullptr, 0, nullptr, (bf16*)(ws + WS_PROJ)};
        pg8::gemm_phase<pg8::Epi<6>, pg8::StaticOrder, PG8_ALIGN, PG8_SP2>(F.lds + RING_OFF, g, S, E);
        if (BOTH(1)) GRID_BAR();
    }
    if (IN(2)) {
        for (int u = c; u < 64 * scn::NSEG; u += F.G) scn::scan_unit(F, u);
        for (int u = c; u < 1024; u += F.G) att::attn_unit(F, u);
        if (BOTH(2)) GRID_BAR();
    }
    if (IN(3)) {
        for (int u = c; u < 64 * scn::NSEG; u += F.G) if (u & (scn::NSEG - 1)) scn::fixup_unit(F, u);
        if (BOTH(3)) GRID_BAR();
    }
    if (IN(4)) { ohnorm_phase(F); if (BOTH(4)) GRID_BAR(); }
    if (IN(5)) {
        pg8::Gemm g{XN, (const bf16*)(ws + WS_WHP), M, D, HW, D / 64, HW}; pg8::StaticOrder S; S.init(M, D, F.G, c);
        pg8::Epi<1> E{P2 + C2_GA, NP2, P2 + C2_GA, NP2, nullptr, 0, nullptr};
        pg8::gemm_phase<pg8::Epi<1>, pg8::StaticOrder, PG8_ALIGN, PG8_SP2>(F.lds + RING_OFF, g, S, E);
        if (BOTH(5)) SELF_ACQ();
    }
    if (IN(6)) {
        pg8::Gemm g{XN + (size_t)(HW / 64) * (256 * 64), (const bf16*)(ws + WS_WAP), M, D, HW, D / 64, HW}; pg8::StaticOrder S; S.init(M, D, F.G, c);
        pg8::Epi<2> E{(bf16*)(ws + WS_Y), D, P2 + C2_GA, NP2, P2 + C2_GB, NP2, nullptr, nullptr, D / 64};
        pg8::gemm_phase<pg8::Epi<2>, pg8::StaticOrder, PG8_ALIGN, PG8_SP2>(F.lds + RING_OFF, g, S, E);
        if (BOTH(6)) GRID_BAR();
    }
    if (IN(7)) {
        pg8::Gemm g{(const bf16*)(ws + WS_Y), (const bf16*)(ws + WS_WOUT), M, D, D, D / 64, D}; pg8::StaticOrder S; S.init(M, D, F.G, c);
        pg8::Epi<3> E{(bf16*)(ws + WS_MIX), D, nullptr, 0, nullptr, 0, SS};
        pg8::gemm_phase<pg8::Epi<3>, pg8::StaticOrder, PG8_ALIGN, PG8_SP2>(F.lds + RING_OFF, g, S, E);
        if (BOTH(7)) GRID_BAR();
    }
    if (IN(8)) { resid_phase<0>(F, (const bf16*)(ws + WS_MIX), F.in[0], XN, (bf16*)F.out, F.in[3], F.in[12]); if (BOTH(8)) GRID_BAR(); }
    if (IN(9)) {
        pg8::Gemm g{XN, (const bf16*)(ws + WS_WUP), M, DFF, D, D / 64, D}; pg8::StaticOrder S; S.init(M, DFF, F.G, c);
        pg8::Epi<4> E{(bf16*)(ws + WS_U), DFF, nullptr, 0, nullptr, 0, nullptr, nullptr, DFF / 64};
        pg8::gemm_phase<pg8::Epi<4>, pg8::StaticOrder, PG8_ALIGN, PG8_SP2>(F.lds + RING_OFF, g, S, E);
        if (BOTH(9)) GRID_BAR();
    }
    if (IN(10)) {
        pg8::Gemm g{(const bf16*)(ws + WS_U), (const bf16*)(ws + WS_WDN), M, D, DFF, DFF / 64, DFF}; pg8::StaticOrder S; S.init(M, D, F.G, c);
        pg8::Epi<3> E{(bf16*)(ws + WS_MIX), D, nullptr, 0, nullptr, 0, SS};
        pg8::gemm_phase<pg8::Epi<3>, pg8::StaticOrder, PG8_ALIGN, PG8_SP2>(F.lds + RING_OFF, g, S, E);
        if (BOTH(10)) GRID_BAR();
    }
    if (IN(11)) { resid_phase<1>(F, (const bf16*)(ws + WS_MIX), F.in[0], (const bf16*)F.out, (bf16*)F.out, F.in[13], nullptr); if (BOTH(11)) GRID_BAR(); }
    if (IN(12)) {
        pg8::Gemm g{(const bf16*)(ws + WS_PBF), (const bf16*)(ws + WS_WPLE), M, D, PLE, PLE / 64, PLE}; pg8::StaticOrder S; S.init(M, D, F.G, c);
        pg8::Epi<0> E{(bf16*)(ws + WS_E), D, nullptr, 0, nullptr, 0, nullptr};
        pg8::gemm_phase<pg8::Epi<0>, pg8::StaticOrder, PG8_ALIGN, PG8_SP2>(F.lds + RING_OFF, g, S, E);
        if (BOTH(12)) SELF_ACQ();
    }
    if (IN(13)) {
        pg8::Gemm g{XN, (const bf16*)(ws + WS_WPG), M, D, D, D / 64, D}; pg8::StaticOrder S; S.init(M, D, F.G, c);
        pg8::Epi<5> E{(bf16*)(ws + WS_V), D, (const bf16*)(ws + WS_E), D, nullptr, 0, SS};
        pg8::gemm_phase<pg8::Epi<5>, pg8::StaticOrder, PG8_ALIGN, PG8_SP2>(F.lds + RING_OFF, g, S, E);
        if (BOTH(13)) GRID_BAR();
    }
    if (IN(14)) { resid_phase<2>(F, (const bf16*)(ws + WS_V), F.in[0], XN, (bf16*)F.out, F.in[18], nullptr); }
#undef IN
#undef BOTH
#undef GRID_BAR
}

extern "C" void kernel_launch(void* const* d_in, const int* in_sizes, int n_in, void* d_out, int out_size, void* d_ws, size_t ws_size, hipStream_t stream) {
    static int grid = 0;
    if (grid == 0) {
        if (n_in != 19 || in_sizes[0] != M * D || out_size != M * D || ws_size < WS_END) { fprintf(stderr, "kernel_launch: unexpected shapes: n_in %d in0 %d out %d ws %zu (need %zu)\n", n_in, n_in > 0 ? in_sizes[0] : -1, out_size, ws_size, (size_t)WS_END); grid = -1; return; }
        int dev = 0, cus = 0, per_cu = 0;
        if (hipGetDevice(&dev) != hipSuccess || hipDeviceGetAttribute(&cus, hipDeviceAttributeMultiprocessorCount, dev) != hipSuccess) { fprintf(stderr, "kernel_launch: device query failed\n"); grid = -1; return; }
        if (hipFuncSetAttribute((const void*)skel_fwd, hipFuncAttributeMaxDynamicSharedMemorySize, LDS_BYTES) != hipSuccess) { fprintf(stderr, "kernel_launch: hipFuncSetAttribute failed\n"); grid = -1; return; }
        if (hipOccupancyMaxActiveBlocksPerMultiprocessor(&per_cu, (const void*)skel_fwd, NWAVES * 64, LDS_BYTES) != hipSuccess || per_cu < 1)
            fprintf(stderr, "kernel_launch: note: occupancy query reports %d workgroups per CU\n", per_cu);
        (void)hipGetLastError();
        grid = cus;
    }
    if (grid < 0) return;
    if (hipMemsetAsync((char*)d_ws + WS_CTL, 0, CTL_ZERO_BYTES, stream) != hipSuccess) { fprintf(stderr, "kernel_launch: memset failed\n"); return; }
    Args a{};
    for (int i = 0; i < 19; ++i) a.in[i] = (const float*)d_in[i];
    a.out = (float*)d_out; a.ws = (unsigned char*)d_ws;
    const int nl = ONE_LAUNCH ? 1 : NPH;
    for (int li = 0; li < nl; ++li) {
        a.ph_lo = ONE_LAUNCH ? 0 : li; a.ph_hi = ONE_LAUNCH ? NPH : li + 1; a.li = li; a.pad = 0;
        hipLaunchKernelGGL(skel_fwd, dim3(grid), dim3(NWAVES * 64), LDS_BYTES, stream, a);
        const hipError_t le = hipPeekAtLastError();
        if (le != hipSuccess) { fprintf(stderr, "kernel_launch: launch %d failed: %s\n", li, hipGetErrorName(le)); break; }
    }
}
```
